# Optimizing an MI355X kernel written in HIP

```python
import math
import jax
import jax.numpy as jnp
from jax import lax
import numpy as np

D_MODEL = 1024
BATCH = 8
SEQ = 4096
DEPTH = 2

HEAD_DIM = 64
BLOCK_Q = 128
NORM_EPS = 1e-6
NEG_INF = -1e30
ATTN_SCALE = HEAD_DIM ** -0.5

SWA_HEADS = 4
SWA_KV_HEADS = 2
SWA_GROUP = SWA_HEADS // SWA_KV_HEADS
SWA_WINDOW = 128
FOX_HEADS = 4
SB_HEADS = 4
DSA_HEADS = 4
IDX_HEADS = 4
IDX_DIM = 64
IDX_SCALE = IDX_DIM ** -0.5
DSA_TOPK_MAX = 256
T5_BUCKETS = 32
T5_MAX_DISTANCE = 128
T5_HEADS = SWA_HEADS + DSA_HEADS
N_BRANCHES = 4
BRANCH_WIDTH = 4 * HEAD_DIM
N_GROUPS = 4
EXPERTS_PER_GROUP = 8
N_EXPERTS = N_GROUPS * EXPERTS_PER_GROUP
EXPERT_FF = 512
TOP_K_IN_GROUP = 2
MOE_BLOCK = 128

IN_SPLITS = (
    SWA_HEADS * HEAD_DIM, SWA_KV_HEADS * HEAD_DIM, SWA_KV_HEADS * HEAD_DIM,
    FOX_HEADS * HEAD_DIM, FOX_HEADS * HEAD_DIM, FOX_HEADS * HEAD_DIM,
    FOX_HEADS,
    SB_HEADS * HEAD_DIM, SB_HEADS * HEAD_DIM, SB_HEADS * HEAD_DIM,
    DSA_HEADS * HEAD_DIM, HEAD_DIM, HEAD_DIM,
    IDX_HEADS * IDX_DIM, IDX_DIM, IDX_HEADS,
    N_BRANCHES * D_MODEL,
)
IN_COLS = sum(IN_SPLITS)

kernel_name = 'hybrid_gated_swa_fox_stickbreak_dsa_hmoe'


def rms_norm(t, g):
    tf = t.astype(jnp.float32)
    tf = tf * lax.rsqrt(jnp.mean(tf * tf, axis=-1, keepdims=True) + NORM_EPS)
    return (tf * g.astype(jnp.float32)).astype(t.dtype)


def t5_bucket(dist):
    n = jnp.maximum(dist, 0)
    max_exact = T5_BUCKETS // 2
    nf = jnp.maximum(n, 1).astype(jnp.float32)
    large = max_exact + (jnp.log(nf / max_exact) / math.log(T5_MAX_DISTANCE / max_exact)
                         * (T5_BUCKETS - max_exact)).astype(jnp.int32)
    large = jnp.minimum(large, T5_BUCKETS - 1)
    return jnp.where(n < max_exact, n, large)


def to_blocks(t):
    b, s = t.shape[:2]
    return jnp.moveaxis(t.reshape((b, s // BLOCK_Q, BLOCK_Q) + t.shape[2:]), 1, 0)


def from_blocks(o):
    nb, b = o.shape[:2]
    return jnp.moveaxis(o, 0, 1).reshape(b, nb * BLOCK_Q, -1)


def sliding_window_attention(q, k, v, sinks, bias_table):
    b, s_len = q.shape[:2]
    nb = s_len // BLOCK_Q
    qb = q.reshape(b, nb, BLOCK_Q, SWA_KV_HEADS, SWA_GROUP, HEAD_DIM)

    def band(t):
        tb = t.reshape(b, nb, BLOCK_Q, SWA_KV_HEADS, HEAD_DIM)
        prev = jnp.concatenate([jnp.zeros_like(tb[:, :1]), tb[:, :-1]], axis=1)
        return jnp.concatenate([prev, tb], axis=2)

    kw, vw = band(k), band(v)
    s = jnp.einsum('bnqkgd,bnskd->bnkgqs', qb, kw).astype(jnp.float32) * ATTN_SCALE
    qi = jnp.arange(BLOCK_Q)[:, None]
    kj = jnp.arange(2 * BLOCK_Q)[None, :]
    dist = BLOCK_Q + qi - kj
    bias = bias_table[t5_bucket(dist)].astype(jnp.float32)
    bias = jnp.transpose(bias, (2, 0, 1)).reshape(SWA_KV_HEADS, SWA_GROUP, BLOCK_Q, 2 * BLOCK_Q)
    kpos = (jnp.arange(nb)[:, None, None] - 1) * BLOCK_Q + kj[None]
    valid = (dist >= 0) & (dist < SWA_WINDOW) & (kpos >= 0)
    s = jnp.where(valid[None, :, None, None], s + bias, NEG_INF)
    sink = sinks.astype(jnp.float32).reshape(1, 1, SWA_KV_HEADS, SWA_GROUP, 1, 1)
    m = jnp.maximum(jnp.max(s, axis=-1, keepdims=True), sink)
    p = jnp.exp(s - m)
    denom = jnp.sum(p, axis=-1, keepdims=True) + jnp.exp(sink - m)
    p = (p / denom).astype(v.dtype)
    o = jnp.einsum('bnkgqs,bnskd->bnqkgd', p, vw)
    return o.reshape(b, s_len, SWA_HEADS * HEAD_DIM)


def forgetting_attention(q, k, v, log_f):
    s_len = q.shape[1]
    c = jnp.cumsum(log_f, axis=1)
    c_keys = jnp.swapaxes(c, 1, 2)
    kpos = jnp.arange(s_len)

    def block(args):
        i, qi, ci = args
        s = jnp.einsum('bqhd,bshd->bhqs', qi, k).astype(jnp.float32) * ATTN_SCALE
        s = s + jnp.swapaxes(ci, 1, 2)[..., None] - c_keys[:, :, None, :]
        qpos = i * BLOCK_Q + jnp.arange(BLOCK_Q)
        s = jnp.where(kpos[None, :] <= qpos[:, None], s, NEG_INF)
        p = jax.nn.softmax(s, axis=-1).astype(v.dtype)
        return jnp.einsum('bhqs,bshd->bqhd', p, v)

    nb = s_len // BLOCK_Q
    out = lax.map(block, (jnp.arange(nb), to_blocks(q), to_blocks(c)))
    return from_blocks(out)


def stick_breaking_attention(q, k, v):
    s_len = q.shape[1]
    kpos = jnp.arange(s_len)

    def block(args):
        i, qi = args
        z = jnp.einsum('bqhd,bshd->bhqs', qi, k).astype(jnp.float32) * ATTN_SCALE
        qpos = i * BLOCK_Q + jnp.arange(BLOCK_Q)
        strict = kpos[None, :] < qpos[:, None]
        log_beta = jax.nn.log_sigmoid(z)
        log_keep = jnp.where(strict, jax.nn.log_sigmoid(-z), 0.0)
        later = lax.cumsum(log_keep, axis=3, reverse=True) - log_keep
        a = jnp.where(strict, jnp.exp(log_beta + later), 0.0).astype(v.dtype)
        return jnp.einsum('bhqs,bshd->bqhd', a, v)

    nb = s_len // BLOCK_Q
    out = lax.map(block, (jnp.arange(nb), to_blocks(q)))
    return from_blocks(out)


def dsa_attention(q, k, v, q_idx, k_idx, w_idx, bias_table):
    s_len = k.shape[1]
    top_k = min(DSA_TOPK_MAX, s_len // 4)
    kpos = jnp.arange(s_len)
    gather = jax.vmap(lambda t, idx: t[idx])

    def block(args):
        i, qi, qii, wi = args
        qpos = i * BLOCK_Q + jnp.arange(BLOCK_Q)
        idx_logits = jnp.einsum('bqhd,bsd->bqhs', qii, k_idx).astype(jnp.float32) * IDX_SCALE
        score = jnp.einsum('bqh,bqhs->bqs', wi.astype(jnp.float32) * IDX_HEADS ** -0.5,
                           jax.nn.relu(idx_logits))
        score = jnp.where(kpos[None, None, :] <= qpos[None, :, None], score, -jnp.inf)
        _, idx = lax.top_k(score, top_k)
        kg = gather(k, idx)
        vg = gather(v, idx)
        s = jnp.einsum('bqhd,bqkd->bhqk', qi, kg).astype(jnp.float32) * ATTN_SCALE
        dist = qpos[None, :, None] - idx
        bias = jnp.moveaxis(bias_table[t5_bucket(dist)], -1, 1).astype(jnp.float32)
        s = jnp.where((dist >= 0)[:, None], s + bias, NEG_INF)
        p = jax.nn.softmax(s, axis=-1).astype(v.dtype)
        return jnp.einsum('bhqk,bqkd->bqhd', p, vg)

    nb = s_len // BLOCK_Q
    out = lax.map(block, (jnp.arange(nb), to_blocks(q), to_blocks(q_idx), to_blocks(w_idx)))
    return from_blocks(out)


def hierarchical_moe(h, w_rg, b_rg, w_re, b_re, w_up, w_down):
    n_tok, d = h.shape
    g_logits = (h @ w_rg).astype(jnp.float32) + b_rg.astype(jnp.float32)
    g_prob = jax.nn.softmax(g_logits, axis=-1)
    grp = jnp.argmax(g_logits, axis=-1).astype(jnp.int32)
    p_grp = jnp.take_along_axis(g_prob, grp[:, None], axis=1)[:, 0]
    e_logits = ((h @ w_re).astype(jnp.float32) + b_re.astype(jnp.float32)).reshape(
        n_tok, N_GROUPS, EXPERTS_PER_GROUP)
    e_in = jnp.take_along_axis(e_logits, grp[:, None, None], axis=1)[:, 0]
    top_p, top_e = lax.top_k(jax.nn.softmax(e_in, axis=-1), TOP_K_IN_GROUP)
    gate = p_grp[:, None] * top_p / jnp.sum(top_p, axis=-1, keepdims=True)
    expert = grp[:, None] * EXPERTS_PER_GROUP + top_e.astype(jnp.int32)

    n_assign = n_tok * TOP_K_IN_GROUP
    flat_e = expert.reshape(-1)
    flat_tok = jnp.repeat(jnp.arange(n_tok, dtype=jnp.int32), TOP_K_IN_GROUP)
    flat_gate = gate.reshape(-1)
    order = jnp.argsort(flat_e)
    se, stok, sgate = flat_e[order], flat_tok[order], flat_gate[order]
    counts = jnp.bincount(flat_e, length=N_EXPERTS).astype(jnp.int32)
    start = jnp.cumsum(counts) - counts
    padded = (counts + MOE_BLOCK - 1) // MOE_BLOCK * MOE_BLOCK
    pend = jnp.cumsum(padded)
    pstart = pend - padded
    pos = pstart[se] + (jnp.arange(n_assign, dtype=jnp.int32) - start[se])
    n_blocks = -(-n_assign // MOE_BLOCK) + N_EXPERTS
    slot_tok = jnp.full((n_blocks * MOE_BLOCK,), n_tok, jnp.int32).at[pos].set(stok)
    blk_expert = jnp.clip(jnp.searchsorted(pend, jnp.arange(n_blocks) * MOE_BLOCK, side='right'),
                          0, N_EXPERTS - 1)
    h_pad = jnp.concatenate([h, jnp.zeros((1, d), h.dtype)], axis=0)
    xb = h_pad[slot_tok].reshape(n_blocks, MOE_BLOCK, d)

    def expert_block(args):
        xi, e = args
        gu = xi @ w_up[e]
        g, u = jnp.split(gu, 2, axis=-1)
        return (jax.nn.silu(g) * u) @ w_down[e]

    yb = lax.map(expert_block, (xb, blk_expert)).reshape(n_blocks * MOE_BLOCK, d)
    contrib = yb[pos] * sgate[:, None].astype(yb.dtype)
    return jnp.zeros((n_tok, d), h.dtype).at[stok].add(contrib)


def setup_inputs(seed: int = 0) -> dict:
    key = jax.random.key(seed)
    ks = jax.random.split(key, 17)
    f32 = jnp.float32
    nrm = lambda k, shp: jax.random.normal(k, shp, f32)
    return {
        'x': nrm(ks[0], (BATCH, SEQ, D_MODEL)),
        'norm_mix_g': 1.0 + 0.02 * nrm(ks[1], (DEPTH, D_MODEL)),
        'w_in': nrm(ks[2], (DEPTH, D_MODEL, IN_COLS)) * D_MODEL ** -0.5,
        'forget_bias': jax.random.uniform(ks[3], (DEPTH, FOX_HEADS), f32, 1.0, 5.0),
        'attn_sinks': 0.5 * nrm(ks[4], (DEPTH, SWA_HEADS)),
        'qk_gain': 1.0 + 0.02 * nrm(ks[5], (DEPTH, 3, 2, HEAD_DIM)),
        'w_branch': nrm(ks[6], (DEPTH, N_BRANCHES, BRANCH_WIDTH, D_MODEL)) * BRANCH_WIDTH ** -0.5,
        'w_out': nrm(ks[7], (DEPTH, D_MODEL, D_MODEL)) * D_MODEL ** -0.5,
        't5_table': 0.5 * nrm(ks[8], (T5_BUCKETS, T5_HEADS)),
        'norm_ffn_g': 1.0 + 0.02 * nrm(ks[9], (DEPTH, D_MODEL)),
        'w_router_group': nrm(ks[10], (DEPTH, D_MODEL, N_GROUPS)) * D_MODEL ** -0.5,
        'b_router_group': 0.01 * nrm(ks[11], (DEPTH, N_GROUPS)),
        'w_router_expert': nrm(ks[12], (DEPTH, D_MODEL, N_EXPERTS)) * D_MODEL ** -0.5,
        'b_router_expert': 0.01 * nrm(ks[13], (DEPTH, N_EXPERTS)),
        'w_expert_up': nrm(ks[14], (DEPTH, N_EXPERTS, D_MODEL, 2 * EXPERT_FF)) * D_MODEL ** -0.5,
        'w_expert_down': nrm(ks[15], (DEPTH, N_EXPERTS, EXPERT_FF, D_MODEL)) * EXPERT_FF ** -0.5,
    }


def reference(x, norm_mix_g, w_in, forget_bias, attn_sinks, qk_gain, w_branch, w_out, t5_table,
              norm_ffn_g, w_router_group, b_router_group, w_router_expert, b_router_expert,
              w_expert_up, w_expert_down):
    b, s = x.shape[:2]
    offsets = np.cumsum(IN_SPLITS)[:-1].tolist()
    for layer in range(DEPTH):
        h = rms_norm(x, norm_mix_g[layer])
        proj = h @ w_in[layer]
        (a_q, a_k, a_v, f_q, f_k, f_v, f_gate, s_q, s_k, s_v,
         d_q, d_k, d_v, i_q, i_k, i_w, gate_cols) = jnp.split(proj, offsets, axis=-1)
        gq = qk_gain[layer]
        heads = lambda t, n: t.reshape(b, s, n, HEAD_DIM)

        o_swa = sliding_window_attention(
            rms_norm(heads(a_q, SWA_HEADS), gq[0, 0]),
            rms_norm(heads(a_k, SWA_KV_HEADS), gq[0, 1]),
            heads(a_v, SWA_KV_HEADS),
            attn_sinks[layer], t5_table[:, :SWA_HEADS])

        log_f = jax.nn.log_sigmoid(f_gate.astype(jnp.float32) + forget_bias[layer].astype(jnp.float32))
        o_fox = forgetting_attention(
            rms_norm(heads(f_q, FOX_HEADS), gq[1, 0]),
            rms_norm(heads(f_k, FOX_HEADS), gq[1, 1]),
            heads(f_v, FOX_HEADS), log_f)

        o_sb = stick_breaking_attention(heads(s_q, SB_HEADS), heads(s_k, SB_HEADS), heads(s_v, SB_HEADS))

        o_dsa = dsa_attention(
            rms_norm(heads(d_q, DSA_HEADS), gq[2, 0]),
            rms_norm(d_k, gq[2, 1]), d_v,
            i_q.reshape(b, s, IDX_HEADS, IDX_DIM), i_k, i_w,
            t5_table[:, SWA_HEADS:])

        g_swa, g_fox, g_sb, g_dsa = jnp.split(jax.nn.sigmoid(gate_cols), N_BRANCHES, axis=-1)
        wb = w_branch[layer]
        merged = (g_swa * (o_swa @ wb[0]) + g_fox * (o_fox @ wb[1])
                  + g_sb * (o_sb @ wb[2]) + g_dsa * (o_dsa @ wb[3]))
        x = x + merged @ w_out[layer]

        h2 = rms_norm(x, norm_ffn_g[layer]).reshape(b * s, D_MODEL)
        y = hierarchical_moe(h2, w_router_group[layer], b_router_group[layer],
                             w_router_expert[layer], b_router_expert[layer],
                             w_expert_up[layer], w_expert_down[layer])
        x = x + y.reshape(b, s, D_MODEL)
    return x
```

```cpp
#include <hip/hip_runtime.h>
#include <hip/hip_cooperative_groups.h>
#include <stdint.h>
#include <stdio.h>

typedef unsigned short bf16_t;
typedef short bf16x8 __attribute__((ext_vector_type(8)));
typedef float f32x4 __attribute__((ext_vector_type(4)));
typedef unsigned u32x4 __attribute__((ext_vector_type(4)));
typedef unsigned u32x2 __attribute__((ext_vector_type(2)));
typedef unsigned long long u64;

#define DI __device__ __forceinline__

constexpr int NB = 8, SEQ = 4096, NT = NB * SEQ, DM = 1024;
constexpr int INC = 6856;
constexpr int PW = 2816;
constexpr int NEXP = 32, EFF = 512;
constexpr int NSLOT = 2 * NT + NEXP * 128;
constexpr int U_AQ = 0, U_AK = 4, U_AV = 6, U_FQ = 8, U_FK = 12, U_FV = 16, U_SQ = 20, U_SK = 24, U_SV = 28,
              U_DQ = 32, U_DK = 36, U_DV = 37, U_IQ = 38, U_IK = 42, U_SM = 43;
constexpr long SC_PER_B = 1024L * 8256L;

constexpr size_t AL(size_t x) { return (x + 255) & ~(size_t)255; }
constexpr size_t OFF_WIN = 0;
constexpr size_t OFF_WBR = OFF_WIN + AL(2UL * 6912 * 1024 * 2);
constexpr size_t OFF_WOUT = OFF_WBR + AL(2UL * 4 * 1024 * 256 * 2);
constexpr size_t OFF_UP = OFF_WOUT + AL(2UL * 1024 * 1024 * 2);
constexpr size_t OFF_DOWN = OFF_UP + AL(2UL * 32 * 1024 * 1024 * 2);
constexpr size_t OFF_HB = OFF_DOWN + AL(2UL * 32 * 1024 * 512 * 2);
constexpr size_t OFF_P = OFF_HB + AL((size_t)NT * 1024 * 2);
constexpr size_t OFF_MG = OFF_P;
constexpr size_t OFF_ACT = OFF_P + AL((size_t)NT * 1024 * 2);
constexpr size_t OFF_VT = OFF_P + AL((size_t)NT * PW * 2);
constexpr size_t OFF_LOGF = OFF_VT + AL(8UL * 11 * 64 * 4096 * 2);
constexpr size_t OFF_CT = OFF_LOGF + AL((size_t)NT * 4 * 4);
constexpr size_t OFF_IW = OFF_CT + AL((size_t)NT * 4 * 4);
constexpr size_t OFF_R = OFF_IW + AL((size_t)NT * 4 * 4);
constexpr size_t OFF_Y = OFF_R;
constexpr size_t OFF_O = OFF_R + AL((size_t)NSLOT * 1024 * 4);
constexpr size_t OFF_MASK = OFF_O + AL((size_t)NT * 1024 * 2);
constexpr size_t OFF_TOKE = OFF_MASK + AL((size_t)NT * 512);
constexpr size_t OFF_TOKG = OFF_TOKE + AL((size_t)NT * 8);
constexpr size_t OFF_SLT = OFF_TOKG + AL((size_t)NT * 8);
constexpr size_t OFF_SLG = OFF_SLT + AL((size_t)NSLOT * 4);
constexpr size_t OFF_CNT = OFF_SLG + AL((size_t)NSLOT * 4);
constexpr size_t OFF_TPOS = OFF_CNT + 1024;
constexpr size_t WS_END = OFF_TPOS + AL((size_t)NT * 8);
static_assert(8UL * SC_PER_B * 4 <= (size_t)NSLOT * 1024 * 4, "R region");
static_assert(WS_END <= (1UL << 30), "workspace");

struct Params {
  const float* x; const float* norm_mix_g; const float* w_in; const float* forget_bias; const float* attn_sinks;
  const float* qk_gain; const float* w_branch; const float* w_out; const float* t5; const float* norm_ffn_g;
  const float* w_rg; const float* b_rg; const float* w_re; const float* b_re; const float* w_up; const float* w_down;
  float* out; char* ws;
};

DI float bf2f(bf16_t v) { return __uint_as_float(((unsigned)v) << 16); }
DI bf16_t f2bf(float f) { unsigned u = __float_as_uint(f); u += 0x7fffu + ((u >> 16) & 1u); return (bf16_t)(u >> 16); }
DI unsigned pack2(float lo, float hi) { return (unsigned)f2bf(lo) | ((unsigned)f2bf(hi) << 16); }
DI float wave_sum(float v) { for (int o = 32; o > 0; o >>= 1) v += __shfl_xor(v, o); return v; }
DI float wave_max(float v) { for (int o = 32; o > 0; o >>= 1) v = fmaxf(v, __shfl_xor(v, o)); return v; }
DI float log_sigmoid_f(float x) { return fminf(x, 0.f) - log1pf(expf(-fabsf(x))); }

__device__ const unsigned char T5B[128] = {
  0, 1, 2, 3, 4, 5, 6, 7, 8, 9, 10, 11, 12, 13, 14, 15, 16, 16, 16, 17, 17, 18, 18, 18, 19, 19, 19, 20, 20, 20, 20, 21,
  21, 21, 21, 22, 22, 22, 22, 22, 23, 23, 23, 23, 23, 23, 24, 24, 24, 24, 24, 24, 25, 25, 25, 25, 25, 25, 25, 26, 26, 26, 26, 26,
  26, 26, 26, 27, 27, 27, 27, 27, 27, 27, 27, 27, 27, 28, 28, 28, 28, 28, 28, 28, 28, 28, 28, 29, 29, 29, 29, 29, 29, 29, 29, 29,
  29, 29, 29, 30, 30, 30, 30, 30, 30, 30, 30, 30, 30, 30, 30, 30, 30, 31, 31, 31, 31, 31, 31, 31, 31, 31, 31, 31, 31, 31, 31, 31};
DI int t5_bucket(int dist) { return T5B[dist > 127 ? 127 : dist]; }

DI void load_row64(const bf16_t* p, float* q) {
#pragma unroll
  for (int i = 0; i < 8; ++i) {
    u32x4 v = *(const u32x4*)(p + i * 8);
#pragma unroll
    for (int j = 0; j < 4; ++j) { q[i * 8 + 2 * j] = __uint_as_float(v[j] << 16); q[i * 8 + 2 * j + 1] = __uint_as_float(v[j] & 0xffff0000u); }
  }
}
DI float dot_row64(const bf16_t* p, const float* q) {
  float acc = 0.f;
#pragma unroll
  for (int i = 0; i < 8; ++i) {
    u32x4 v = *(const u32x4*)(p + i * 8);
#pragma unroll
    for (int j = 0; j < 4; ++j) { acc += q[i * 8 + 2 * j] * __uint_as_float(v[j] << 16); acc += q[i * 8 + 2 * j + 1] * __uint_as_float(v[j] & 0xffff0000u); }
  }
  return acc;
}

DI int colmap(int mode, int n) {
  if (mode == 0) return n;
  if (mode == 1) {
    if (n < 1280) return n;
    if (n < 2752) return n + 4;
    if (n < 2756) return 1280 + (n - 2752);
    if (n < 2760) return n;
    if (n < 2816) return -1;
    return n - 56;
  }
  int blk = n >> 5, w = n & 31;
  return (w < 16) ? (blk * 16 + w) : (512 + blk * 16 + (w - 16));
}
DI void transpose_tile(const float* __restrict__ src, int Nsrc, int K, bf16_t* __restrict__ dst, int n0, int k0, int mode, float (*tile)[33]) {
  const int tx = threadIdx.x & 31, ty = threadIdx.x >> 5;
  const int col = colmap(mode, n0 + tx);
#pragma unroll
  for (int i = 0; i < 4; ++i) { int kk = ty + 8 * i; tile[kk][tx] = (col >= 0) ? src[(size_t)(k0 + kk) * Nsrc + col] : 0.f; }
  __syncthreads();
#pragma unroll
  for (int i = 0; i < 4; ++i) { int nn = ty + 8 * i; dst[(size_t)(n0 + nn) * K + k0 + tx] = f2bf(tile[tx][nn]); }
  __syncthreads();
}
constexpr int T_IN = 216 * 32, T_BR = 4 * 32 * 8, T_OUT = 32 * 32, T_UP = 32 * 32 * 32, T_DN = 32 * 32 * 16;
constexpr int T_LAYER = T_IN + T_BR + T_OUT + T_UP + T_DN;
__device__ void phase_convert(const Params& p, int bid, int nblk, char* smem) {
  float (*tile)[33] = (float (*)[33])smem;
  for (int it = bid; it < 2 * T_LAYER; it += nblk) {
    int l = it / T_LAYER, r = it % T_LAYER;
    if (r < T_IN) {
      int nt = r / 32, kt = r % 32;
      transpose_tile(p.w_in + (size_t)l * 1024 * INC, INC, 1024, (bf16_t*)(p.ws + OFF_WIN) + (size_t)l * 6912 * 1024, nt * 32, kt * 32, 1, tile);
    } else if ((r -= T_IN) < T_BR) {
      int b = r / 256, q = r % 256, nt = q / 8, kt = q % 8;
      transpose_tile(p.w_branch + ((size_t)l * 4 + b) * 256 * 1024, 1024, 256, (bf16_t*)(p.ws + OFF_WBR) + ((size_t)l * 4 + b) * 1024 * 256, nt * 32, kt * 32, 0, tile);
    } else if ((r -= T_BR) < T_OUT) {
      int nt = r / 32, kt = r % 32;
      transpose_tile(p.w_out + (size_t)l * 1024 * 1024, 1024, 1024, (bf16_t*)(p.ws + OFF_WOUT) + (size_t)l * 1024 * 1024, nt * 32, kt * 32, 0, tile);
    } else if ((r -= T_OUT) < T_UP) {
      int e = r / 1024, q = r % 1024, nt = q / 32, kt = q % 32;
      transpose_tile(p.w_up + ((size_t)l * 32 + e) * 1024 * 1024, 1024, 1024, (bf16_t*)(p.ws + OFF_UP) + ((size_t)l * 32 + e) * 1024 * 1024, nt * 32, kt * 32, 2, tile);
    } else {
      r -= T_UP;
      int e = r / 512, q = r % 512, nt = q / 16, kt = q % 16;
      transpose_tile(p.w_down + ((size_t)l * 32 + e) * 512 * 1024, 1024, 512, (bf16_t*)(p.ws + OFF_DOWN) + ((size_t)l * 32 + e) * 1024 * 512, nt * 32, kt * 32, 0, tile);
    }
  }
  if (bid == 0 && threadIdx.x < 128) ((int*)(p.ws + OFF_CNT))[threadIdx.x] = 0;
}

__device__ void phase_norm(const float* __restrict__ xin, const float* __restrict__ g, bf16_t* __restrict__ hb, int bid, int nblk) {
  const int lane = threadIdx.x & 63, wid = threadIdx.x >> 6;
  for (int row = bid * 4 + wid; row < NT; row += nblk * 4) {
    const float* xr = xin + (size_t)row * DM;
    f32x4 v[4]; float ss = 0.f;
#pragma unroll
    for (int i = 0; i < 4; ++i) { v[i] = *(const f32x4*)(xr + lane * 4 + 256 * i); ss += v[i][0] * v[i][0] + v[i][1] * v[i][1] + v[i][2] * v[i][2] + v[i][3] * v[i][3]; }
    ss = wave_sum(ss);
    const float r = rsqrtf(ss * (1.f / DM) + 1e-6f);
#pragma unroll
    for (int i = 0; i < 4; ++i) {
      f32x4 gg = *(const f32x4*)(g + lane * 4 + 256 * i);
      u32x2 o; o[0] = pack2(v[i][0] * r * gg[0], v[i][1] * r * gg[1]); o[1] = pack2(v[i][2] * r * gg[2], v[i][3] * r * gg[3]);
      *(u32x2*)(hb + (size_t)row * DM + lane * 4 + 256 * i) = o;
    }
  }
}

typedef __attribute__((address_space(3))) void* lds_ptr_t;
template <class ARow>
DI void gemm_kloop(f32x4 (&acc)[4][4], ARow arow, const bf16_t* __restrict__ Bt, int ldb, int K, char* smem) {
  const int tid = threadIdx.x, wid = tid >> 6, lane = tid & 63, wr = wid >> 1, wc = wid & 1, fr = lane & 15, fq = lane >> 4;
  char* SA = smem; char* SB = smem + 8192;
  const bf16_t* ap[2]; const bf16_t* bp[2];
#pragma unroll
  for (int i = 0; i < 2; ++i) { int r = (tid >> 2) + i * 64, c = (tid & 3) * 8; ap[i] = arow(r) + c; bp[i] = Bt + (size_t)r * ldb + c; }
  for (int kt = 0; kt < K; kt += 32) {
#pragma unroll
    for (int i = 0; i < 2; ++i) {
      __builtin_amdgcn_global_load_lds((const void __attribute__((address_space(1)))*)(ap[i] + kt), (lds_ptr_t)(SA + tid * 16 + i * 4096), 16, 0, 0);
      __builtin_amdgcn_global_load_lds((const void __attribute__((address_space(1)))*)(bp[i] + kt), (lds_ptr_t)(SB + tid * 16 + i * 4096), 16, 0, 0);
    }
    asm volatile("s_waitcnt vmcnt(0)" ::: "memory");
    __syncthreads();
    bf16x8 af[4], bfr[4];
#pragma unroll
    for (int m = 0; m < 4; ++m) af[m] = *(const bf16x8*)(SA + ((wr * 64 + m * 16 + fr) * 32 + fq * 8) * 2);
#pragma unroll
    for (int n = 0; n < 4; ++n) bfr[n] = *(const bf16x8*)(SB + ((wc * 64 + n * 16 + fr) * 32 + fq * 8) * 2);
#pragma unroll
    for (int m = 0; m < 4; ++m)
#pragma unroll
      for (int n = 0; n < 4; ++n) acc[m][n] = __builtin_amdgcn_mfma_f32_16x16x32_bf16(bfr[n], af[m], acc[m][n], 0, 0, 0);
    __syncthreads();
  }
}
DI void zero_acc(f32x4 (&acc)[4][4]) {
#pragma unroll
  for (int m = 0; m < 4; ++m)
#pragma unroll
    for (int n = 0; n < 4; ++n) acc[m][n] = (f32x4){0.f, 0.f, 0.f, 0.f};
}
struct RowsDense { const bf16_t* base; int ld; DI const bf16_t* operator()(int r) const { return base + (size_t)r * ld; } };

__device__ void phase_inproj(const Params& p, int layer, int bid, int nblk, char* smem) {
  const bf16_t* hb = (const bf16_t*)(p.ws + OFF_HB);
  const bf16_t* wt = (const bf16_t*)(p.ws + OFF_WIN) + (size_t)layer * 6912 * 1024;
  bf16_t* P = (bf16_t*)(p.ws + OFF_P); bf16_t* VT = (bf16_t*)(p.ws + OFF_VT);
  float* LOGF = (float*)(p.ws + OFF_LOGF); float* IW = (float*)(p.ws + OFF_IW);
  const int tid = threadIdx.x, wid = tid >> 6, lane = tid & 63, wr = wid >> 1, wc = wid & 1, fr = lane & 15, fq = lane >> 4;
  constexpr int NTN = PW / 128;
  for (int tile = bid; tile < (NT / 128) * NTN; tile += nblk) {
    const int mt = tile / NTN, nt = tile % NTN;
    f32x4 acc[4][4]; zero_acc(acc);
    gemm_kloop(acc, RowsDense{hb + (size_t)mt * 128 * DM, DM}, wt + (size_t)nt * 128 * DM, DM, DM, smem);
    const int unit = nt * 2 + wc;
    int gsel = -1; float scale = 1.f; int vh = -1;
    if (unit < 4) { gsel = 0; scale = 0.125f; } else if (unit < 6) gsel = 1;
    else if (unit < 8) vh = unit - 6;
    else if (unit < 12) { gsel = 2; scale = 0.125f; } else if (unit < 16) gsel = 3;
    else if (unit < 20) vh = 2 + unit - 16;
    else if (unit < 24) scale = 0.125f;
    else if (unit >= 28 && unit < 32) vh = 6 + unit - 28;
    else if (unit >= 32 && unit < 36) { gsel = 4; scale = 0.125f; } else if (unit == 36) gsel = 5;
    else if (unit == 37) vh = 10;
    else if (unit >= 38 && unit < 42) scale = 0.125f;
    const float* gain = p.qk_gain + (size_t)layer * 384 + (gsel < 0 ? 0 : gsel) * 64;
#pragma unroll
    for (int m = 0; m < 4; ++m) {
      const int tok = mt * 128 + wr * 64 + m * 16 + fr;
      if (unit == U_SM) {
        if (fq == 0) {
          f32x4 v = acc[m][0]; f32x4 o;
#pragma unroll
          for (int j = 0; j < 4; ++j) o[j] = log_sigmoid_f(v[j] + p.forget_bias[layer * 4 + j]);
          *(f32x4*)(LOGF + (size_t)tok * 4) = o;
        } else if (fq == 1) {
          f32x4 v = acc[m][0];
          *(f32x4*)(IW + (size_t)tok * 4) = v * 0.5f;
        }
        continue;
      }
      float r = 1.f;
      if (gsel >= 0) {
        float ss = 0.f;
#pragma unroll
        for (int n = 0; n < 4; ++n)
#pragma unroll
          for (int j = 0; j < 4; ++j) ss += acc[m][n][j] * acc[m][n][j];
        ss += __shfl_xor(ss, 16); ss += __shfl_xor(ss, 32);
        r = rsqrtf(ss * (1.f / 64.f) + 1e-6f);
      }
#pragma unroll
      for (int n = 0; n < 4; ++n) {
        const int c = n * 16 + fq * 4;
        f32x4 v = acc[m][n];
        if (gsel >= 0) { f32x4 gg = *(const f32x4*)(gain + c); v = v * r * gg; }
        v = v * scale;
        u32x2 o; o[0] = pack2(v[0], v[1]); o[1] = pack2(v[2], v[3]);
        *(u32x2*)(P + (size_t)tok * PW + unit * 64 + c) = o;
        if (vh >= 0) {
          const int b = tok >> 12, s = tok & 4095;
#pragma unroll
          for (int j = 0; j < 4; ++j) VT[(((size_t)b * 11 + vh) * 64 + c + j) * 4096 + s] = f2bf(v[j]);
        }
      }
    }
  }
}

__device__ void phase_cumsum(const Params& p, int bid, int nblk) {
  const float* LOGF = (const float*)(p.ws + OFF_LOGF); float* CT = (float*)(p.ws + OFF_CT);
  const int lane = threadIdx.x & 63, wid = threadIdx.x >> 6;
  for (int seq = bid * 4 + wid; seq < 32; seq += nblk * 4) {
    const int b = seq >> 2, h = seq & 3;
    float tot = 0.f;
    for (int i = 0; i < 64; ++i) tot += LOGF[((size_t)b * 4096 + lane * 64 + i) * 4 + h];
    float incl = tot;
    for (int o = 1; o < 64; o <<= 1) { float t = __shfl_up(incl, o); if (lane >= o) incl += t; }
    float run = incl - tot;
    for (int i = 0; i < 64; ++i) { run += LOGF[((size_t)b * 4096 + lane * 64 + i) * 4 + h]; CT[((size_t)b * 4 + h) * 4096 + lane * 64 + i] = run; }
  }
}

__device__ void naive_swa(const Params& p, int layer, int item, int lane) {
  const bf16_t* P = (const bf16_t*)(p.ws + OFF_P); bf16_t* O = (bf16_t*)(p.ws + OFF_O);
  const int t = item & 4095, hq = (item >> 12) & 3, b = item >> 14, tok = b * 4096 + t, kv = hq >> 1;
  float q[64]; load_row64(P + (size_t)tok * PW + (U_AQ + hq) * 64, q);
  float sc[2];
#pragma unroll
  for (int i = 0; i < 2; ++i) {
    const int dist = lane + 64 * i, s = t - dist;
    sc[i] = -INFINITY;
    if (s >= 0) sc[i] = dot_row64(P + (size_t)(b * 4096 + s) * PW + (U_AK + kv) * 64, q) + p.t5[t5_bucket(dist) * 8 + hq];
  }
  const float sink = p.attn_sinks[layer * 4 + hq];
  const float m = fmaxf(wave_max(fmaxf(sc[0], sc[1])), sink);
  float pr[2]; pr[0] = expf(sc[0] - m); pr[1] = expf(sc[1] - m);
  const float denom = wave_sum(pr[0] + pr[1]) + expf(sink - m);
  float o = 0.f;
#pragma unroll
  for (int i = 0; i < 2; ++i)
    for (int j = 0; j < 64; ++j) {
      const int s = t - j - 64 * i; const float pj = __shfl(pr[i], j);
      if (s >= 0) o += pj * bf2f(P[(size_t)(b * 4096 + s) * PW + (U_AV + kv) * 64 + lane]);
    }
  O[(size_t)tok * 1024 + hq * 64 + lane] = f2bf(o / denom);
}
__device__ void naive_fox(const Params& p, int item, int lane) {
  const bf16_t* P = (const bf16_t*)(p.ws + OFF_P); bf16_t* O = (bf16_t*)(p.ws + OFF_O); const float* CT = (const float*)(p.ws + OFF_CT);
  const int t = item & 4095, h = (item >> 12) & 3, b = item >> 14, tok = b * 4096 + t;
  float q[64]; load_row64(P + (size_t)tok * PW + (U_FQ + h) * 64, q);
  const float* c = CT + ((size_t)b * 4 + h) * 4096; const float ct = c[t];
  float m = -INFINITY, l = 0.f, o = 0.f;
  for (int c0 = 0; c0 <= t; c0 += 64) {
    const int s = c0 + lane; const bool valid = s <= t;
    float sc = -INFINITY;
    if (valid) sc = dot_row64(P + (size_t)(b * 4096 + s) * PW + (U_FK + h) * 64, q) + (ct - c[s]);
    const float mn = fmaxf(m, wave_max(sc));
    const float alpha = expf(m - mn);
    const float pl = valid ? expf(sc - mn) : 0.f;
    l = l * alpha + pl; o *= alpha; m = mn;
    for (int j = 0; j < 64; ++j) { const int sj = c0 + j; const float pj = __shfl(pl, j); if (sj <= t) o += pj * bf2f(P[(size_t)(b * 4096 + sj) * PW + (U_FV + h) * 64 + lane]); }
  }
  O[(size_t)tok * 1024 + 256 + h * 64 + lane] = f2bf(o / wave_sum(l));
}
__device__ void naive_sb(const Params& p, int item, int lane) {
  const bf16_t* P = (const bf16_t*)(p.ws + OFF_P); bf16_t* O = (bf16_t*)(p.ws + OFF_O);
  const int t = item & 4095, h = (item >> 12) & 3, b = item >> 14, tok = b * 4096 + t;
  float q[64]; load_row64(P + (size_t)tok * PW + (U_SQ + h) * 64, q);
  float R = 0.f, o = 0.f;
  for (int c0 = t - 1; c0 >= 0; c0 -= 64) {
    const int s = c0 - lane; const bool valid = s >= 0;
    float z = 0.f;
    if (valid) z = dot_row64(P + (size_t)(b * 4096 + s) * PW + (U_SK + h) * 64, q);
    const float lk = valid ? log_sigmoid_f(-z) : 0.f;
    float incl = lk;
    for (int d = 1; d < 64; d <<= 1) { float tt = __shfl_up(incl, d); if (lane >= d) incl += tt; }
    const float later = R + incl - lk;
    const float a = valid ? expf(log_sigmoid_f(z) + later) : 0.f;
    R += __shfl(incl, 63);
    for (int j = 0; j < 64; ++j) { const int sj = c0 - j; const float aj = __shfl(a, j); if (sj >= 0) o += aj * bf2f(P[(size_t)(b * 4096 + sj) * PW + (U_SV + h) * 64 + lane]); }
  }
  O[(size_t)tok * 1024 + 512 + h * 64 + lane] = f2bf(o);
}
DI size_t sc_row_off(int b, int t) { const int i = t >> 5; return (size_t)b * SC_PER_B + 1024UL * ((size_t)i * (i + 1) / 2) + (size_t)(t & 31) * (size_t)((i + 1) * 32); }
__device__ void naive_idx(const Params& p, int item, int lane, float* qs  ) {
  const bf16_t* P = (const bf16_t*)(p.ws + OFF_P); const float* IW = (const float*)(p.ws + OFF_IW); float* SC = (float*)(p.ws + OFF_R);
  const int t = item & 4095, b = item >> 12, tok = b * 4096 + t;
  for (int i = lane; i < 256; i += 64) qs[i] = bf2f(P[(size_t)tok * PW + U_IQ * 64 + i]);
  float w[4];
#pragma unroll
  for (int h = 0; h < 4; ++h) w[h] = IW[(size_t)tok * 4 + h];
  const int rowlen = ((t >> 5) + 1) * 32;
  float* row = SC + sc_row_off(b, t);
  for (int c0 = 0; c0 < rowlen; c0 += 64) {
    const int s = c0 + lane;
    if (s < rowlen) {
      float score = -INFINITY;
      if (s <= t) {
        float k[64]; load_row64(P + (size_t)(b * 4096 + s) * PW + U_IK * 64, k);
        score = 0.f;
#pragma unroll
        for (int h = 0; h < 4; ++h) {
          float d = 0.f;
#pragma unroll
          for (int e = 0; e < 64; ++e) d += qs[h * 64 + e] * k[e];
          score += w[h] * fmaxf(d, 0.f);
        }
        score += 0.f;
      }
      row[s] = score;
    }
  }
}
__device__ void dsa_select(const Params& p, int item, int lane) {
  const float* SC = (const float*)(p.ws + OFF_R); u64* MASK = (u64*)(p.ws + OFF_MASK);
  const int t = item & 4095, b = item >> 12, tok = b * 4096 + t;
  const float* row = SC + sc_row_off(b, t);
  u64 myword = 0;
  if (t < 256) {
#pragma unroll
    for (int r = 0; r < 4; ++r) { u64 w = __ballot((r * 64 + lane) <= t); if (lane == r) myword = w; }
  } else {
    unsigned u[64];
#pragma unroll
    for (int r = 0; r < 64; ++r) {
      const int s = r * 64 + lane; unsigned key = 0;
      if (s <= t) { unsigned bits = __float_as_uint(row[s]); key = (bits & 0x80000000u) ? ~bits : (bits | 0x80000000u); }
      u[r] = key;
    }
    unsigned T = 0;
    for (int bit = 31; bit >= 0; --bit) {
      const unsigned cand = T | (1u << bit); int cnt = 0;
#pragma unroll
      for (int r = 0; r < 64; ++r) cnt += __builtin_popcountll(__ballot(u[r] >= cand));
      if (cnt >= 256) T = cand;
    }
    int cgt = 0;
#pragma unroll
    for (int r = 0; r < 64; ++r) cgt += __builtin_popcountll(__ballot(u[r] > T));
    int need = 256 - cgt;
#pragma unroll
    for (int r = 0; r < 64; ++r) {
      const u64 gt = __ballot(u[r] > T); u64 eq = __ballot(u[r] == T);
      int ne = __builtin_popcountll(eq);
      if (ne > need) { int drop = ne - need; while (drop-- > 0) eq &= ~(1ULL << (63 - __builtin_clzll(eq))); ne = need; }
      need -= ne;
      const u64 w = gt | eq;
      if (lane == r) myword = w;
    }
  }
  MASK[(size_t)tok * 64 + lane] = myword;
}
__device__ void naive_dsa(const Params& p, int item, int lane) {
  const bf16_t* P = (const bf16_t*)(p.ws + OFF_P); bf16_t* O = (bf16_t*)(p.ws + OFF_O); const u64* MASK = (const u64*)(p.ws + OFF_MASK);
  const int t = item & 4095, h = (item >> 12) & 3, b = item >> 14, tok = b * 4096 + t;
  float q[64]; load_row64(P + (size_t)tok * PW + (U_DQ + h) * 64, q);
  float m = -INFINITY, l = 0.f, o = 0.f;
  for (int c0 = 0; c0 <= t; c0 += 64) {
    const u64 word = MASK[(size_t)tok * 64 + (c0 >> 6)];
    const int s = c0 + lane; const bool valid = (s <= t) && ((word >> lane) & 1ULL);
    float sc = -INFINITY;
    if (valid) sc = dot_row64(P + (size_t)(b * 4096 + s) * PW + U_DK * 64, q) + p.t5[t5_bucket(t - s) * 8 + 4 + h];
    const float cm = wave_max(sc);
    if (cm == -INFINITY) continue;
    const float mn = fmaxf(m, cm);
    const float alpha = expf(m - mn);
    const float pl = valid ? expf(sc - mn) : 0.f;
    l = l * alpha + pl; o *= alpha; m = mn;
    for (int j = 0; j < 64; ++j) { const float pj = __shfl(pl, j); if ((word >> j) & 1ULL) o += pj * bf2f(P[(size_t)(b * 4096 + c0 + j) * PW + U_DV * 64 + lane]); }
  }
  O[(size_t)tok * 1024 + 768 + h * 64 + lane] = f2bf(o / wave_sum(l));
}

__device__ void phase_attn1(const Params& p, int layer, int bid, int nblk, char* smem) {
  const int lane = threadIdx.x & 63, wid = threadIdx.x >> 6, gw = bid * 4 + wid, nw = nblk * 4;
  phase_cumsum(p, bid, nblk);
  for (int it = gw; it < NB * 4 * SEQ; it += nw) naive_swa(p, layer, it, lane);
  for (int it = gw; it < NB * 4 * SEQ; it += nw) naive_sb(p, it, lane);
  float* qs = (float*)smem + wid * 256;
  for (int it = gw; it < NB * SEQ; it += nw) naive_idx(p, it, lane, qs);
}
__device__ void phase_attn2(const Params& p, int layer, int bid, int nblk) {
  const int lane = threadIdx.x & 63, wid = threadIdx.x >> 6, gw = bid * 4 + wid, nw = nblk * 4;
  for (int it = gw; it < NB * SEQ; it += nw) dsa_select(p, it, lane);
  for (int it = gw; it < NB * 4 * SEQ; it += nw) naive_fox(p, it, lane);
}
__device__ void phase_attn3(const Params& p, int layer, int bid, int nblk) {
  const int lane = threadIdx.x & 63, wid = threadIdx.x >> 6, gw = bid * 4 + wid, nw = nblk * 4;
  for (int it = gw; it < NB * 4 * SEQ; it += nw) naive_dsa(p, it, lane);
}

__device__ void phase_gates(const Params& p, int layer, int bid, int nblk, char* smem) {
  const bf16_t* hb = (const bf16_t*)(p.ws + OFF_HB);
  const bf16_t* wt = (const bf16_t*)(p.ws + OFF_WIN) + ((size_t)layer * 6912 + PW) * 1024;
  bf16_t* G = (bf16_t*)(p.ws + OFF_R);
  const int tid = threadIdx.x, wid = tid >> 6, lane = tid & 63, wr = wid >> 1, wc = wid & 1, fr = lane & 15, fq = lane >> 4;
  for (int tile = bid; tile < 256 * 32; tile += nblk) {
    const int mt = tile >> 5, nt = tile & 31;
    f32x4 acc[4][4]; zero_acc(acc);
    gemm_kloop(acc, RowsDense{hb + (size_t)mt * 128 * DM, DM}, wt + (size_t)nt * 128 * DM, DM, DM, smem);
#pragma unroll
    for (int m = 0; m < 4; ++m) {
      const int tok = mt * 128 + wr * 64 + m * 16 + fr;
#pragma unroll
      for (int n = 0; n < 4; ++n) {
        const int col = nt * 128 + wc * 64 + n * 16 + fq * 4;
        f32x4 v = acc[m][n]; u32x2 o;
        float s0 = 1.f / (1.f + expf(-v[0])), s1 = 1.f / (1.f + expf(-v[1])), s2 = 1.f / (1.f + expf(-v[2])), s3 = 1.f / (1.f + expf(-v[3]));
        o[0] = pack2(s0, s1); o[1] = pack2(s2, s3);
        *(u32x2*)(G + (size_t)tok * 4096 + col) = o;
      }
    }
  }
}

__device__ void phase_merge(const Params& p, int layer, int bid, int nblk, char* smem) {
  const bf16_t* O = (const bf16_t*)(p.ws + OFF_O); const bf16_t* G = (const bf16_t*)(p.ws + OFF_R);
  const bf16_t* wt = (const bf16_t*)(p.ws + OFF_WBR) + (size_t)layer * 4 * 1024 * 256;
  bf16_t* MG = (bf16_t*)(p.ws + OFF_MG);
  const int tid = threadIdx.x, wid = tid >> 6, lane = tid & 63, wr = wid >> 1, wc = wid & 1, fr = lane & 15, fq = lane >> 4;
  for (int tile = bid; tile < 256 * 8; tile += nblk) {
    const int mt = tile >> 3, nt = tile & 7;
    f32x4 macc[4][4]; zero_acc(macc);
    for (int b = 0; b < 4; ++b) {
      f32x4 acc[4][4]; zero_acc(acc);
      gemm_kloop(acc, RowsDense{O + (size_t)mt * 128 * 1024 + b * 256, 1024}, wt + ((size_t)b * 1024 + nt * 128) * 256, 256, 256, smem);
#pragma unroll
      for (int m = 0; m < 4; ++m) {
        const int tok = mt * 128 + wr * 64 + m * 16 + fr;
#pragma unroll
        for (int n = 0; n < 4; ++n) {
          const int col = nt * 128 + wc * 64 + n * 16 + fq * 4;
          u32x2 g = *(const u32x2*)(G + (size_t)tok * 4096 + b * 1024 + col);
          macc[m][n][0] += __uint_as_float(g[0] << 16) * acc[m][n][0];
          macc[m][n][1] += __uint_as_float(g[0] & 0xffff0000u) * acc[m][n][1];
          macc[m][n][2] += __uint_as_float(g[1] << 16) * acc[m][n][2];
          macc[m][n][3] += __uint_as_float(g[1] & 0xffff0000u) * acc[m][n][3];
        }
      }
    }
#pragma unroll
    for (int m = 0; m < 4; ++m) {
      const int tok = mt * 128 + wr * 64 + m * 16 + fr;
#pragma unroll
      for (int n = 0; n < 4; ++n) {
        const int col = nt * 128 + wc * 64 + n * 16 + fq * 4;
        u32x2 o; o[0] = pack2(macc[m][n][0], macc[m][n][1]); o[1] = pack2(macc[m][n][2], macc[m][n][3]);
        *(u32x2*)(MG + (size_t)tok * 1024 + col) = o;
      }
    }
  }
}

__device__ void phase_outproj(const Params& p, int layer, const float* __restrict__ xin, int bid, int nblk, char* smem) {
  const bf16_t* MG = (const bf16_t*)(p.ws + OFF_MG);
  const bf16_t* wt = (const bf16_t*)(p.ws + OFF_WOUT) + (size_t)layer * 1024 * 1024;
  const int tid = threadIdx.x, wid = tid >> 6, lane = tid & 63, wr = wid >> 1, wc = wid & 1, fr = lane & 15, fq = lane >> 4;
  for (int tile = bid; tile < 256 * 8; tile += nblk) {
    const int mt = tile >> 3, nt = tile & 7;
    f32x4 acc[4][4]; zero_acc(acc);
    gemm_kloop(acc, RowsDense{MG + (size_t)mt * 128 * 1024, 1024}, wt + (size_t)nt * 128 * 1024, 1024, 1024, smem);
#pragma unroll
    for (int m = 0; m < 4; ++m) {
      const int tok = mt * 128 + wr * 64 + m * 16 + fr;
#pragma unroll
      for (int n = 0; n < 4; ++n) {
        const int col = nt * 128 + wc * 64 + n * 16 + fq * 4;
        f32x4 xv = *(const f32x4*)(xin + (size_t)tok * 1024 + col);
        *(f32x4*)(p.out + (size_t)tok * 1024 + col) = xv + acc[m][n];
      }
    }
  }
}

__device__ void phase_router(const Params& p, int layer, int bid, int nblk) {
  const int lane = threadIdx.x & 63, wid = threadIdx.x >> 6;
  bf16_t* hb = (bf16_t*)(p.ws + OFF_HB);
  int* TOKE = (int*)(p.ws + OFF_TOKE); float* TOKG = (float*)(p.ws + OFF_TOKG); int* CNT = (int*)(p.ws + OFF_CNT) + layer * 64;
  const float* g = p.norm_ffn_g + (size_t)layer * DM;
  const float* wrg = p.w_rg + (size_t)layer * DM * 4; const float* wre = p.w_re + (size_t)layer * DM * 32;
  for (int tok = bid * 4 + wid; tok < NT; tok += nblk * 4) {
    const float* xr = p.out + (size_t)tok * DM;
    f32x4 v[4]; float ss = 0.f;
#pragma unroll
    for (int i = 0; i < 4; ++i) { v[i] = *(const f32x4*)(xr + lane * 4 + 256 * i); ss += v[i][0] * v[i][0] + v[i][1] * v[i][1] + v[i][2] * v[i][2] + v[i][3] * v[i][3]; }
    ss = wave_sum(ss);
    const float r = rsqrtf(ss * (1.f / DM) + 1e-6f);
    float lg[4] = {0.f, 0.f, 0.f, 0.f}; float le[32];
#pragma unroll
    for (int e = 0; e < 32; ++e) le[e] = 0.f;
#pragma unroll
    for (int i = 0; i < 4; ++i) {
      f32x4 gg = *(const f32x4*)(g + lane * 4 + 256 * i);
      f32x4 h = v[i] * r * gg;
      u32x2 o; o[0] = pack2(h[0], h[1]); o[1] = pack2(h[2], h[3]);
      *(u32x2*)(hb + (size_t)tok * DM + lane * 4 + 256 * i) = o;
#pragma unroll
      for (int j = 0; j < 4; ++j) {
        const int c = lane * 4 + 256 * i + j;
        f32x4 wg = *(const f32x4*)(wrg + (size_t)c * 4);
#pragma unroll
        for (int e = 0; e < 4; ++e) lg[e] += h[j] * wg[e];
#pragma unroll
        for (int e4 = 0; e4 < 8; ++e4) {
          f32x4 we = *(const f32x4*)(wre + (size_t)c * 32 + e4 * 4);
#pragma unroll
          for (int e = 0; e < 4; ++e) le[e4 * 4 + e] += h[j] * we[e];
        }
      }
    }
#pragma unroll
    for (int e = 0; e < 4; ++e) lg[e] = wave_sum(lg[e]) + p.b_rg[layer * 4 + e];
#pragma unroll
    for (int e = 0; e < 32; ++e) le[e] = wave_sum(le[e]) + p.b_re[layer * 32 + e];
    int grp = 0; float gm = lg[0];
#pragma unroll
    for (int e = 1; e < 4; ++e) if (lg[e] > gm) { gm = lg[e]; grp = e; }
    float gs = 0.f;
#pragma unroll
    for (int e = 0; e < 4; ++e) gs += expf(lg[e] - gm);
    const float p_grp = 1.f / gs;
    float ei[8];
#pragma unroll
    for (int j = 0; j < 8; ++j) ei[j] = grp == 0 ? le[j] : (grp == 1 ? le[8 + j] : (grp == 2 ? le[16 + j] : le[24 + j]));
    float em = ei[0];
#pragma unroll
    for (int j = 1; j < 8; ++j) em = fmaxf(em, ei[j]);
    float pe[8]; float es = 0.f;
#pragma unroll
    for (int j = 0; j < 8; ++j) { pe[j] = expf(ei[j] - em); es += pe[j]; }
#pragma unroll
    for (int j = 0; j < 8; ++j) pe[j] = pe[j] / es;
    int i0 = 0; float p0 = pe[0];
#pragma unroll
    for (int j = 1; j < 8; ++j) if (pe[j] > p0) { p0 = pe[j]; i0 = j; }
    int i1 = -1; float p1 = -1.f;
#pragma unroll
    for (int j = 0; j < 8; ++j) if (j != i0 && pe[j] > p1) { p1 = pe[j]; i1 = j; }
    if (lane == 0) {
      const float den = p0 + p1;
      TOKE[tok * 2] = grp * 8 + i0; TOKE[tok * 2 + 1] = grp * 8 + i1;
      TOKG[tok * 2] = p_grp * p0 / den; TOKG[tok * 2 + 1] = p_grp * p1 / den;
      atomicAdd(&CNT[grp * 8 + i0], 1); atomicAdd(&CNT[grp * 8 + i1], 1);
    }
  }
}

DI void load_expert_table(const Params& p, int layer, int* tab) {
  const int* CNT = (const int*)(p.ws + OFF_CNT) + layer * 64;
  if (threadIdx.x == 0) {
    int acc = 0;
    for (int e = 0; e < 32; ++e) { int c = CNT[e]; int pad = (c + 127) / 128 * 128; tab[e] = acc; acc += pad; tab[32 + e] = acc; tab[64 + e] = c; }
  }
  __syncthreads();
}
__device__ void phase_slots(const Params& p, int layer, int bid, int nblk, char* smem) {
  int* tab = (int*)smem; load_expert_table(p, layer, tab);
  const int* TOKE = (const int*)(p.ws + OFF_TOKE); const float* TOKG = (const float*)(p.ws + OFF_TOKG);
  int* CUR = (int*)(p.ws + OFF_CNT) + layer * 64 + 32; int* SLT = (int*)(p.ws + OFF_SLT); float* SLG = (float*)(p.ws + OFF_SLG); int* TPOS = (int*)(p.ws + OFF_TPOS);
  for (int a = bid * 256 + threadIdx.x; a < 2 * NT; a += nblk * 256) {
    const int e = TOKE[a];
    const int pos = tab[e] + atomicAdd(&CUR[e], 1);
    SLT[pos] = a >> 1; SLG[pos] = TOKG[a]; TPOS[a] = pos;
  }
  __syncthreads();
}

struct RowsGather { const bf16_t* base; const int* slt; int slot0; int nvalid; DI const bf16_t* operator()(int r) const { int tok = (r < nvalid) ? slt[slot0 + r] : 0; return base + (size_t)tok * DM; } };
__device__ void phase_up(const Params& p, int layer, int bid, int nblk, char* smem) {
  int* tab = (int*)(smem + 16384); load_expert_table(p, layer, tab);
  const bf16_t* hb = (const bf16_t*)(p.ws + OFF_HB); const int* SLT = (const int*)(p.ws + OFF_SLT);
  const bf16_t* wt = (const bf16_t*)(p.ws + OFF_UP) + (size_t)layer * 32 * 1024 * 1024;
  bf16_t* ACT = (bf16_t*)(p.ws + OFF_ACT);
  const int tid = threadIdx.x, wid = tid >> 6, lane = tid & 63, wr = wid >> 1, wc = wid & 1, fr = lane & 15, fq = lane >> 4;
  const int ntiles_m = tab[63] / 128;
  for (int tile = bid; tile < ntiles_m * 8; tile += nblk) {
    const int mt = tile >> 3, nt = tile & 7, slot0 = mt * 128;
    int e = 0;
    for (int k = 0; k < 32; ++k) if (slot0 >= tab[32 + k]) e = k + 1;
    const int nvalid = tab[e] + tab[64 + e] - slot0;
    f32x4 acc[4][4]; zero_acc(acc);
    gemm_kloop(acc, RowsGather{hb, SLT, slot0, nvalid}, wt + ((size_t)e * 1024 + nt * 128) * 1024, 1024, 1024, smem);
#pragma unroll
    for (int m = 0; m < 4; ++m) {
      const int slot = slot0 + wr * 64 + m * 16 + fr;
#pragma unroll
      for (int n2 = 0; n2 < 2; ++n2) {
        f32x4 gv = acc[m][2 * n2], uv = acc[m][2 * n2 + 1]; float a[4];
#pragma unroll
        for (int j = 0; j < 4; ++j) a[j] = gv[j] / (1.f + expf(-gv[j])) * uv[j];
        u32x2 o; o[0] = pack2(a[0], a[1]); o[1] = pack2(a[2], a[3]);
        *(u32x2*)(ACT + (size_t)slot * EFF + nt * 64 + wc * 32 + n2 * 16 + fq * 4) = o;
      }
    }
  }
  __syncthreads();
}
__device__ void phase_down(const Params& p, int layer, int bid, int nblk, char* smem) {
  int* tab = (int*)(smem + 16384); load_expert_table(p, layer, tab);
  const bf16_t* ACT = (const bf16_t*)(p.ws + OFF_ACT); float* Y = (float*)(p.ws + OFF_Y);
  const bf16_t* wt = (const bf16_t*)(p.ws + OFF_DOWN) + (size_t)layer * 32 * 1024 * 512;
  const int tid = threadIdx.x, wid = tid >> 6, lane = tid & 63, wr = wid >> 1, wc = wid & 1, fr = lane & 15, fq = lane >> 4;
  const int ntiles_m = tab[63] / 128;
  for (int tile = bid; tile < ntiles_m * 8; tile += nblk) {
    const int mt = tile >> 3, nt = tile & 7, slot0 = mt * 128;
    int e = 0;
    for (int k = 0; k < 32; ++k) if (slot0 >= tab[32 + k]) e = k + 1;
    const int nvalid = tab[e] + tab[64 + e] - slot0;
    f32x4 acc[4][4]; zero_acc(acc);
    gemm_kloop(acc, RowsDense{ACT + (size_t)slot0 * EFF, EFF}, wt + ((size_t)e * 1024 + nt * 128) * 512, 512, 512, smem);
#pragma unroll
    for (int m = 0; m < 4; ++m) {
      const int r = wr * 64 + m * 16 + fr;
#pragma unroll
      for (int n = 0; n < 4; ++n) {
        const int col = nt * 128 + wc * 64 + n * 16 + fq * 4;
        *(f32x4*)(Y + (size_t)(slot0 + r) * 1024 + col) = acc[m][n];
      }
    }
  }
  __syncthreads();
}
__device__ void phase_combine(const Params& p, int bid, int nblk) {
  const float* Y = (const float*)(p.ws + OFF_Y); const int* TPOS = (const int*)(p.ws + OFF_TPOS); const float* TOKG = (const float*)(p.ws + OFF_TOKG);
  const int lane = threadIdx.x & 63, wid = threadIdx.x >> 6;
  for (int tok = bid * 4 + wid; tok < NT; tok += nblk * 4) {
    const int p0 = TPOS[tok * 2], p1 = TPOS[tok * 2 + 1]; const float g0 = TOKG[tok * 2], g1 = TOKG[tok * 2 + 1];
#pragma unroll
    for (int i = 0; i < 4; ++i) {
      const int c = lane * 4 + 256 * i;
      f32x4 xv = *(const f32x4*)(p.out + (size_t)tok * DM + c);
      f32x4 y0 = *(const f32x4*)(Y + (size_t)p0 * DM + c), y1 = *(const f32x4*)(Y + (size_t)p1 * DM + c);
      *(f32x4*)(p.out + (size_t)tok * DM + c) = xv + (y0 * g0 + y1 * g1);
    }
  }
}

template <int phase> __global__ void __launch_bounds__(256) k_phase(Params p, int layer) {
  __shared__ __attribute__((aligned(16))) char smem[16384 + 512];
  const int bid = blockIdx.x, nblk = gridDim.x;
  const float* xin = layer == 0 ? p.x : p.out;
  switch (phase) {
    case 0: phase_convert(p, bid, nblk, smem); break;
    case 1: phase_norm(xin, p.norm_mix_g + (size_t)layer * DM, (bf16_t*)(p.ws + OFF_HB), bid, nblk); break;
    case 2: phase_inproj(p, layer, bid, nblk, smem); break;
    case 3: phase_attn1(p, layer, bid, nblk, smem); break;
    case 4: phase_attn2(p, layer, bid, nblk); break;
    case 5: phase_attn3(p, layer, bid, nblk); break;
    case 6: phase_gates(p, layer, bid, nblk, smem); break;
    case 7: phase_merge(p, layer, bid, nblk, smem); break;
    case 8: phase_outproj(p, layer, xin, bid, nblk, smem); break;
    case 9: phase_router(p, layer, bid, nblk); break;
    case 10: phase_slots(p, layer, bid, nblk, smem); break;
    case 11: phase_up(p, layer, bid, nblk, smem); break;
    case 12: phase_down(p, layer, bid, nblk, smem); break;
    case 13: phase_combine(p, bid, nblk); break;
  }
}

extern "C" void kernel_launch(void* const* d_in, const int* in_sizes, int n_in, void* d_out, int out_size, void* d_ws, size_t ws_size,
                              hipStream_t stream) {
  Params p{};
  p.x = (const float*)d_in[0]; p.norm_mix_g = (const float*)d_in[1]; p.w_in = (const float*)d_in[2]; p.forget_bias = (const float*)d_in[3];
  p.attn_sinks = (const float*)d_in[4]; p.qk_gain = (const float*)d_in[5]; p.w_branch = (const float*)d_in[6]; p.w_out = (const float*)d_in[7];
  p.t5 = (const float*)d_in[8]; p.norm_ffn_g = (const float*)d_in[9]; p.w_rg = (const float*)d_in[10]; p.b_rg = (const float*)d_in[11];
  p.w_re = (const float*)d_in[12]; p.b_re = (const float*)d_in[13]; p.w_up = (const float*)d_in[14]; p.w_down = (const float*)d_in[15];
  p.out = (float*)d_out; p.ws = (char*)d_ws;
  if (ws_size < WS_END) { fprintf(stderr, "workspace too small: %zu < %zu\n", ws_size, (size_t)WS_END); return; }
  const int grid = 2048;
  k_phase<0><<<grid, 256, 0, stream>>>(p, 0);
  for (int layer = 0; layer < 2; ++layer) {
    k_phase<1><<<grid, 256, 0, stream>>>(p, layer); k_phase<2><<<grid, 256, 0, stream>>>(p, layer); k_phase<3><<<grid, 256, 0, stream>>>(p, layer);
    k_phase<4><<<grid, 256, 0, stream>>>(p, layer); k_phase<5><<<grid, 256, 0, stream>>>(p, layer); k_phase<6><<<grid, 256, 0, stream>>>(p, layer);
    k_phase<7><<<grid, 256, 0, stream>>>(p, layer); k_phase<8><<<grid, 256, 0, stream>>>(p, layer); k_phase<9><<<grid, 256, 0, stream>>>(p, layer);
    k_phase<10><<<grid, 256, 0, stream>>>(p, layer); k_phase<11><<<grid, 256, 0, stream>>>(p, layer); k_phase<12><<<grid, 256, 0, stream>>>(p, layer);
    k_phase<13><<<grid, 256, 0, stream>>>(p, layer);
  }
}
```

```cpp
#include <hip/hip_runtime.h>
#include <hip/hip_cooperative_groups.h>
#include <stdint.h>
#include <stdio.h>

typedef unsigned short bf16_t;
typedef short bf16x8 __attribute__((ext_vector_type(8)));
typedef float f32x4 __attribute__((ext_vector_type(4)));
typedef unsigned u32x4 __attribute__((ext_vector_type(4)));
typedef unsigned u32x2 __attribute__((ext_vector_type(2)));
typedef unsigned long long u64;

#define DI __device__ __forceinline__
#ifndef FAST_SWA
#define FAST_SWA 1
#endif
#ifndef FAST_FOX
#define FAST_FOX 1
#endif
#ifndef FAST_SB
#define FAST_SB 1
#endif
#ifndef FAST_DSA
#define FAST_DSA 1
#endif
#ifndef FAST_IDX
#define FAST_IDX 1
#endif
#define PROBE_GEMM 0
#define PROBE_A1 0
#define PROBE_A2 0
#define PROBE_A3 0
#define PROBE_CV 0
#define LOG2E 1.4426950408889634f
#define QS_SWA (FAST_SWA ? 0.125f * LOG2E : 0.125f)
#define QS_FOX (FAST_FOX ? 0.125f * LOG2E : 0.125f)
#define QS_SB (FAST_SB ? 0.125f * LOG2E : 0.125f)
#define QS_DSA (FAST_DSA ? 0.125f * LOG2E : 0.125f)

constexpr int NB = 8, SEQ = 4096, NT = NB * SEQ, DM = 1024;
constexpr int INC = 6856;
constexpr int PW = 2816;
constexpr int NEXP = 32, EFF = 512;
constexpr int NSLOT = 2 * NT + NEXP * 256;
constexpr int NTHR = 512, NWV = 8;
constexpr int U_AQ = 0, U_AK = 4, U_AV = 6, U_FQ = 8, U_FK = 12, U_FV = 16, U_SQ = 20, U_SK = 24, U_SV = 28,
              U_DQ = 32, U_DK = 36, U_DV = 37, U_IQ = 38, U_IK = 42, U_SM = 43;
constexpr long SC_PER_B = 1024L * 8256L;

constexpr size_t AL(size_t x) { return (x + 255) & ~(size_t)255; }
constexpr size_t OFF_WIN = 0;
constexpr size_t OFF_WBR = OFF_WIN + AL(2UL * 6912 * 1024 * 2);
constexpr size_t OFF_WOUT = OFF_WBR + AL(2UL * 4 * 1024 * 256 * 2);
constexpr size_t OFF_UP = OFF_WOUT + AL(2UL * 1024 * 1024 * 2);
constexpr size_t OFF_DOWN = OFF_UP + AL(2UL * 32 * 1024 * 1024 * 2);
constexpr size_t OFF_HB = OFF_DOWN + AL(2UL * 32 * 1024 * 512 * 2);
constexpr size_t OFF_P = OFF_HB + AL((size_t)NT * 1024 * 2);
constexpr size_t OFF_MG = OFF_P;
constexpr size_t OFF_ACT = OFF_P + AL((size_t)NT * 1024 * 2);
constexpr size_t OFF_VT = OFF_P + AL((size_t)NT * PW * 2);
constexpr size_t OFF_LOGF = OFF_VT + AL(8UL * 11 * 64 * 4096 * 2);
constexpr size_t OFF_CT = OFF_LOGF + AL((size_t)NT * 4 * 4);
constexpr size_t OFF_IW = OFF_CT + AL((size_t)NT * 4 * 4);
constexpr size_t OFF_R = OFF_IW + AL((size_t)NT * 4 * 4);
constexpr size_t OFF_Y = OFF_R;
constexpr size_t OFF_O = OFF_R + AL((size_t)NSLOT * 1024 * 4);
constexpr size_t OFF_MASK = OFF_O + AL((size_t)NT * 1024 * 2);
constexpr size_t OFF_TOKE = OFF_MASK + AL((size_t)NT * 512);
constexpr size_t OFF_TOKG = OFF_TOKE + AL((size_t)NT * 8);
constexpr size_t OFF_SLT = OFF_TOKG + AL((size_t)NT * 8);
constexpr size_t OFF_SLG = OFF_SLT + AL((size_t)NSLOT * 4);
constexpr size_t OFF_CNT = OFF_SLG + AL((size_t)NSLOT * 4);
constexpr size_t OFF_TPOS = OFF_CNT + 1024;
constexpr size_t OFF_TCNT = OFF_TPOS + AL((size_t)NT * 8);
constexpr size_t OFF_BAR = OFF_TCNT + AL(256UL * 32 * 4);
constexpr size_t WS_END = OFF_BAR + 16384;
static_assert(8UL * SC_PER_B * 4 <= (size_t)NSLOT * 1024 * 4, "R region");
static_assert(WS_END <= (1UL << 30), "workspace");

struct Params {
  const float* x; const float* norm_mix_g; const float* w_in; const float* forget_bias; const float* attn_sinks;
  const float* qk_gain; const float* w_branch; const float* w_out; const float* t5; const float* norm_ffn_g;
  const float* w_rg; const float* b_rg; const float* w_re; const float* b_re; const float* w_up; const float* w_down;
  float* out; char* ws;
};

DI int opq(int x) { asm volatile("" : "+v"(x)); return x; }
template <class T> DI T* opqp(T* q) { asm volatile("" : "+s"(q)); return q; }
DI int tidx() { int x = __builtin_amdgcn_workitem_id_x(); asm volatile("" : "+v"(x)); return x; }
DI int perm256(int g) { return ((g >> 5) & 3) * 64 + (g >> 7) * 32 + (g & 31); }
DI int perm32(int c) { return ((c >> 2) & 1) * 16 + ((c >> 4) & 1) * 8 + ((c >> 3) & 1) * 4 + (c & 3); }
DI float bf2f(bf16_t v) { return __uint_as_float(((unsigned)v) << 16); }
DI bf16_t f2bf(float f) { unsigned u = __float_as_uint(f); u += 0x7fffu + ((u >> 16) & 1u); return (bf16_t)(u >> 16); }
typedef __bf16 hbf16x2 __attribute__((ext_vector_type(2)));
typedef float f32x2 __attribute__((ext_vector_type(2)));
DI unsigned pack2(float lo, float hi) { f32x2 v = {lo, hi}; return __builtin_bit_cast(unsigned, __builtin_convertvector(v, hbf16x2)); }
DI float wave_sum(float v) { for (int o = 32; o > 0; o >>= 1) v += __shfl_xor(v, o); return v; }
DI float wave_max(float v) { for (int o = 32; o > 0; o >>= 1) v = fmaxf(v, __shfl_xor(v, o)); return v; }
DI float sigmoid_fast(float v) { return __builtin_amdgcn_rcpf(1.f + __builtin_amdgcn_exp2f(-v * 1.4426950408889634f)); }
DI float log_sigmoid_f(float x) { return fminf(x, 0.f) - log1pf(expf(-fabsf(x))); }

__device__ const unsigned char T5B[128] = {
  0, 1, 2, 3, 4, 5, 6, 7, 8, 9, 10, 11, 12, 13, 14, 15, 16, 16, 16, 17, 17, 18, 18, 18, 19, 19, 19, 20, 20, 20, 20, 21,
  21, 21, 21, 22, 22, 22, 22, 22, 23, 23, 23, 23, 23, 23, 24, 24, 24, 24, 24, 24, 25, 25, 25, 25, 25, 25, 25, 26, 26, 26, 26, 26,
  26, 26, 26, 27, 27, 27, 27, 27, 27, 27, 27, 27, 27, 28, 28, 28, 28, 28, 28, 28, 28, 28, 28, 29, 29, 29, 29, 29, 29, 29, 29, 29,
  29, 29, 29, 30, 30, 30, 30, 30, 30, 30, 30, 30, 30, 30, 30, 30, 30, 31, 31, 31, 31, 31, 31, 31, 31, 31, 31, 31, 31, 31, 31, 31};
DI int t5_bucket(int dist) { return T5B[dist > 127 ? 127 : dist]; }

DI void load_row64(const bf16_t* p, float* q) {
#pragma unroll
  for (int i = 0; i < 8; ++i) {
    u32x4 v = *(const u32x4*)(p + i * 8);
#pragma unroll
    for (int j = 0; j < 4; ++j) { q[i * 8 + 2 * j] = __uint_as_float(v[j] << 16); q[i * 8 + 2 * j + 1] = __uint_as_float(v[j] & 0xffff0000u); }
  }
}
DI float dot_row64(const bf16_t* p, const float* q) {
  float acc = 0.f;
#pragma unroll
  for (int i = 0; i < 8; ++i) {
    u32x4 v = *(const u32x4*)(p + i * 8);
#pragma unroll
    for (int j = 0; j < 4; ++j) { acc += q[i * 8 + 2 * j] * __uint_as_float(v[j] << 16); acc += q[i * 8 + 2 * j + 1] * __uint_as_float(v[j] & 0xffff0000u); }
  }
  return acc;
}

#define K8_GATES 1
#define K8_INPROJ 1
#define K8_OUT 1
#define K8_UP 1
#define K8_DOWN 1
DI int colmap(int mode, int n) {
  if (mode == 4) { n = (n & ~255) + perm256(n & 255); mode = 0; }
  if (mode == 5) { n = (n & ~255) + perm256(n & 255); mode = 2; }
  if (mode == 1) { if ((n >= 2816 && K8_GATES) || (n < 2816 && K8_INPROJ)) n = (n & ~255) + perm256(n & 255); }
  if (mode == 0) return n;
  if (mode == 1) {
    if (n < 1280) return n;
    if (n < 2752) return n + 4;
    if (n < 2756) return 1280 + (n - 2752);
    if (n < 2760) return n;
    if (n < 2816) return -1;
    return n - 56;
  }
  int blk = n >> 5, w = n & 31;
  return (w < 16) ? (blk * 16 + w) : (512 + blk * 16 + (w - 16));
}
DI void transpose_tile(const float* __restrict__ src, int Nsrc, int K, bf16_t* __restrict__ dst, int n0, int k0, int mode, float (*tile)[65]) {
  const int t = tidx();
  const int n4 = (t & 15) * 4, kr = t >> 4;
  const int col = colmap(mode, n0 + n4);
  f32x4 v[8];
#pragma unroll
  for (int i = 0; i < 8; ++i) { v[i] = (f32x4){0.f, 0.f, 0.f, 0.f}; if (col >= 0) v[i] = *(const f32x4*)(src + (size_t)(k0 + kr + 32 * i) * Nsrc + col); }
#pragma unroll
  for (int i = 0; i < 8; ++i) { const int kk = kr + 32 * i; tile[kk][n4] = v[i][0]; tile[kk][n4 + 1] = v[i][1]; tile[kk][n4 + 2] = v[i][2]; tile[kk][n4 + 3] = v[i][3]; }
  __syncthreads();
  const int nn = t >> 3;
#pragma unroll
  for (int q = 0; q < 4; ++q) {
    const int k8 = (t & 7) * 8 + 64 * q;
    u32x4 o;
#pragma unroll
    for (int j = 0; j < 4; ++j) o[j] = pack2(tile[k8 + 2 * j][nn], tile[k8 + 2 * j + 1][nn]);
    *(u32x4*)(dst + (size_t)(n0 + nn) * K + k0 + k8) = o;
  }
  __syncthreads();
}
constexpr int T_IN = 108 * 4, T_BR = 4 * 16, T_OUT = 16 * 4, T_UP = 32 * 16 * 4, T_DN = 32 * 16 * 2;
constexpr int T_LAYER = T_IN + T_BR + T_OUT + T_UP + T_DN;
DI void phase_convert(const Params& p, int bid, int nblk, char* smem) {
  char* wsq = opqp(p.ws);
  float (*tile)[65] = (float (*)[65])smem;
  for (int it = bid; it < 2 * T_LAYER; it += nblk) {
    int l = it / T_LAYER, r = it % T_LAYER;
    if (r < T_IN) {
      int nt = r / 4, kt = r % 4;
      transpose_tile(p.w_in + (size_t)l * 1024 * INC, INC, 1024, (bf16_t*)(wsq + OFF_WIN) + (size_t)l * 6912 * 1024, nt * 64, kt * 256, 1, tile);
    } else if ((r -= T_IN) < T_BR) {
      int b = r / 16, nt = r % 16;
      transpose_tile(p.w_branch + (size_t)l * 1024 * 1024, 1024, 1024, (bf16_t*)(wsq + OFF_WBR) + (size_t)l * 1024 * 1024, nt * 64, b * 256, 0, tile);
    } else if ((r -= T_BR) < T_OUT) {
      int nt = r / 4, kt = r % 4;
      transpose_tile(p.w_out + (size_t)l * 1024 * 1024, 1024, 1024, (bf16_t*)(wsq + OFF_WOUT) + (size_t)l * 1024 * 1024, nt * 64, kt * 256, K8_OUT ? 4 : 0, tile);
    } else if ((r -= T_OUT) < T_UP) {
      int e = r / 64, q = r % 64, nt = q / 4, kt = q % 4;
      transpose_tile(p.w_up + ((size_t)l * 32 + e) * 1024 * 1024, 1024, 1024, (bf16_t*)(wsq + OFF_UP) + ((size_t)l * 32 + e) * 1024 * 1024, nt * 64, kt * 256, K8_UP ? 5 : 2, tile);
    } else {
      r -= T_UP;
      int e = r / 32, q = r % 32, nt = q / 2, kt = q % 2;
      transpose_tile(p.w_down + ((size_t)l * 32 + e) * 512 * 1024, 1024, 512, (bf16_t*)(wsq + OFF_DOWN) + ((size_t)l * 32 + e) * 1024 * 512, nt * 64, kt * 256, K8_DOWN ? 4 : 0, tile);
    }
  }
  if (bid == 0 && tidx() < 128) ((int*)(wsq + OFF_CNT))[tidx()] = 0;
}

DI void phase_norm(const float* __restrict__ xin, const float* __restrict__ g, bf16_t* __restrict__ hb, int bid, int nblk) {
  const int lane = tidx() & 63, wid = tidx() >> 6;
  for (int row = bid * NWV + wid; row < NT; row += nblk * NWV) {
    const float* xr = xin + (size_t)row * DM;
    f32x4 v[4]; float ss = 0.f;
#pragma unroll
    for (int i = 0; i < 4; ++i) { v[i] = *(const f32x4*)(xr + lane * 4 + 256 * i); ss += v[i][0] * v[i][0] + v[i][1] * v[i][1] + v[i][2] * v[i][2] + v[i][3] * v[i][3]; }
    ss = wave_sum(ss);
    const float r = rsqrtf(ss * (1.f / DM) + 1e-6f);
#pragma unroll
    for (int i = 0; i < 4; ++i) {
      f32x4 gg = *(const f32x4*)(g + lane * 4 + 256 * i);
      u32x2 o; o[0] = pack2(v[i][0] * r * gg[0], v[i][1] * r * gg[1]); o[1] = pack2(v[i][2] * r * gg[2], v[i][3] * r * gg[3]);
      *(u32x2*)(hb + (size_t)row * DM + lane * 4 + 256 * i) = o;
    }
  }
}

typedef __attribute__((address_space(3))) void* lds_ptr_t;
constexpr int GSTAGE = 65536;
template <int MF, class ARow>
DI void gemm_kloop(f32x4 (&acc)[MF][4], ARow arow, const bf16_t* __restrict__ Bt, int ldb, int K, char* smem) {
  const int tid = tidx(), wid = tid >> 6, lane = tid & 63, wr = wid >> 2, wc = wid & 3, fr = lane & 15, fq = lane >> 4;
  constexpr int AP = MF / 2;
  const bf16_t* ap[AP]; const bf16_t* bp[4];
  const int srow = tid >> 3, sch = tid & 7;
#pragma unroll
  for (int i = 0; i < AP; ++i) { const int r = srow + i * 64; ap[i] = arow(r) + ((sch ^ ((r >> 1) & 7)) << 3); }
#pragma unroll
  for (int i = 0; i < 4; ++i) { const int r = srow + i * 64; bp[i] = Bt + (size_t)r * ldb + ((sch ^ ((r >> 1) & 7)) << 3); }
  auto stage = [&](int buf, int kt) {
    char* SA = smem + buf * GSTAGE; char* SB = SA + 32768;
#pragma unroll
    for (int i = 0; i < AP; ++i)
      __builtin_amdgcn_global_load_lds((const void __attribute__((address_space(1)))*)(ap[i] + kt), (lds_ptr_t)(SA + tid * 16 + i * 8192), 16, 0, 0);
#pragma unroll
    for (int i = 0; i < 4; ++i)
      __builtin_amdgcn_global_load_lds((const void __attribute__((address_space(1)))*)(bp[i] + kt), (lds_ptr_t)(SB + tid * 16 + i * 8192), 16, 0, 0);
  };
  int aoff[MF], boff[4];
#pragma unroll
  for (int m = 0; m < MF; ++m) { const int r = wr * 16 * MF + m * 16 + fr; aoff[m] = r * 128 + ((fq ^ ((r >> 1) & 7)) << 4); }
#pragma unroll
  for (int n = 0; n < 4; ++n) { const int r = wc * 64 + n * 16 + fr; boff[n] = r * 128 + ((fq ^ ((r >> 1) & 7)) << 4); }
  stage(0, 0);
  asm volatile("s_waitcnt vmcnt(0)" ::: "memory");
  __syncthreads();
  int cur = 0;
#pragma unroll 1
  for (int kt = 0; kt < K; kt += 64) {
    if (kt + 64 < K) stage(cur ^ 1, kt + 64);
    const char* SA = smem + cur * GSTAGE; const char* SB = SA + 32768;
    constexpr int NST = 2 * (MF / 4);
    bf16x8 fa[2][4], fb[2][4];
    auto ldfrag = [&](int set, int st) {
      const int ks = st / (MF / 4), mh = st % (MF / 4);
#pragma unroll
      for (int n = 0; n < 4; ++n) fb[set][n] = *(const bf16x8*)(SB + (boff[n] ^ (ks << 6)));
#pragma unroll
      for (int m = 0; m < 4; ++m) fa[set][m] = *(const bf16x8*)(SA + (aoff[mh * 4 + m] ^ (ks << 6)));
    };
    ldfrag(0, 0);
    __builtin_amdgcn_sched_barrier(0);
#pragma unroll
    for (int st = 0; st < NST; ++st) {
      const int mh = st % (MF / 4);
#pragma unroll
      for (int n = 0; n < 4; ++n) acc[mh * 4][n] = __builtin_amdgcn_mfma_f32_16x16x32_bf16(fb[st & 1][n], fa[st & 1][0], acc[mh * 4][n], 0, 0, 0);
      __builtin_amdgcn_sched_barrier(0);
      if (st + 1 < NST) ldfrag((st + 1) & 1, st + 1);
      __builtin_amdgcn_sched_barrier(0);
#pragma unroll
      for (int m = 1; m < 4; ++m)
#pragma unroll
        for (int n = 0; n < 4; ++n) acc[mh * 4 + m][n] = __builtin_amdgcn_mfma_f32_16x16x32_bf16(fb[st & 1][n], fa[st & 1][m], acc[mh * 4 + m][n], 0, 0, 0);
      __builtin_amdgcn_sched_barrier(0);
    }
    asm volatile("s_waitcnt vmcnt(0)" ::: "memory");
    __syncthreads();
    cur ^= 1;
  }
}

DI int k8_lds_byte(int r, int c) { const int st = (r >> 4) * 2 + (c >> 5), rr = r & 15, cc = c & 31, ob = rr * 64 + cc * 2; return st * 1024 + (ob ^ (((ob >> 9) & 1) << 5)); }
DI void k8_stage_rc(int b, int& R, int& C) { const int st = b / 1024, sb = b % 1024, swz = sb ^ (((sb >> 9) & 1) << 5); R = (st >> 1) * 16 + swz / 64; C = (st & 1) * 32 + (swz % 64) / 2; }
template <class ARow>
DI void gemm_kloop8(f32x4 (&acc)[8][4], ARow arow, const bf16_t* __restrict__ Bt, int ldb, int K, char* smem) {
  constexpr int HTB = 16384;
  const int tid = tidx(), wid = tid >> 6, lane = tid & 63, wr = wid >> 2, wc = wid & 3, fr = lane & 15, fq = lane >> 4;
  int R0, C0; k8_stage_rc(tid * 16, R0, C0);
  unsigned aofs[2][2];
  if (!ARow::kDense) {
#pragma unroll
    for (int i = 0; i < 2; ++i)
#pragma unroll
      for (int hf = 0; hf < 2; ++hf) aofs[hf][i] = arow.off(i * 128 + hf * 64 + R0) + C0;
  } else { aofs[0][0] = arow.off(R0) + C0; }
  const unsigned astep = arow.off(64);
  const unsigned bofs0 = (unsigned)R0 * (unsigned)ldb + C0, bstep = 64u * (unsigned)ldb;
  const bf16_t* abase = arow.base;
  typedef const __attribute__((address_space(3))) char* ldsc_t;
  const int lpart = (fr * 64 + fq * 16) ^ ((fr >> 3) << 5);
  const ldsc_t la = (ldsc_t)smem + wr * 8192 + lpart;
  const ldsc_t lb = (ldsc_t)smem + wc * 4096 + lpart;
#define K8_SA(b, h) (((b) * 2 + (h)) * HTB)
#define K8_SB(b, h) ((4 + (b) * 2 + (h)) * HTB)
#define K8_STAGE_A(Pb, hf, kt) do { _Pragma("unroll") for (int _i = 0; _i < 2; ++_i) { \
    unsigned _sc = (unsigned)(kt) * 64u + (ARow::kDense ? ((hf) + 2 * _i) * astep : 0u); asm volatile("" : "+s"(_sc)); \
    __builtin_amdgcn_global_load_lds((const void __attribute__((address_space(1)))*)(abase + ((ARow::kDense ? aofs[0][0] : aofs[hf][_i]) + _sc)), (lds_ptr_t)(smem + (Pb) + tid * 16 + _i * 8192), 16, 0, 0); } } while (0)
#define K8_STAGE_B(Pb, hf, kt) do { _Pragma("unroll") for (int _i = 0; _i < 2; ++_i) { \
    unsigned _sc = (unsigned)(kt) * 64u + (2 * (hf) + _i) * bstep; asm volatile("" : "+s"(_sc)); \
    __builtin_amdgcn_global_load_lds((const void __attribute__((address_space(1)))*)(Bt + (bofs0 + _sc)), (lds_ptr_t)(smem + (Pb) + tid * 16 + _i * 8192), 16, 0, 0); } } while (0)
#define K8_LDA(dst, b, h) do { _Pragma("unroll") for (int m = 0; m < 4; ++m) { _Pragma("unroll") for (int k = 0; k < 2; ++k) \
    dst[m][k] = *(const __attribute__((address_space(3))) bf16x8*)(la + K8_SA(b, h) + (m * 2 + k) * 1024); } } while (0)
#define K8_LDB(dst, b, h) do { _Pragma("unroll") for (int n = 0; n < 2; ++n) { _Pragma("unroll") for (int k = 0; k < 2; ++k) \
    dst[n][k] = *(const __attribute__((address_space(3))) bf16x8*)(lb + K8_SB(b, h) + (n * 2 + k) * 1024); } } while (0)
#define K8_MMA(ai, bj, Af, Bf) do { __builtin_amdgcn_s_setprio(1); \
    _Pragma("unroll") for (int m = 0; m < 4; ++m) { _Pragma("unroll") for (int n = 0; n < 2; ++n) { _Pragma("unroll") for (int k = 0; k < 2; ++k) \
      acc[(ai) * 4 + m][(bj) * 2 + n] = __builtin_amdgcn_mfma_f32_16x16x32_bf16(Bf[n][k], Af[m][k], acc[(ai) * 4 + m][(bj) * 2 + n], 0, 0, 0); } } \
    __builtin_amdgcn_s_setprio(0); } while (0)
#define K8_WV(n) asm volatile("s_waitcnt vmcnt(" #n ")" ::: "memory")
#define K8_WL(n) asm volatile("s_waitcnt lgkmcnt(" #n ")" ::: "memory")
#define K8_BAR __builtin_amdgcn_s_barrier()
#define K8_SCHED __builtin_amdgcn_sched_barrier(0)
  bf16x8 At[4][2], B0[2][2], B1[2][2];
  const int nt = K / 64;
  K8_STAGE_B(K8_SB(0, 0), 0, 0); K8_STAGE_A(K8_SA(0, 0), 0, 0);
  K8_STAGE_B(K8_SB(0, 1), 1, 0); K8_STAGE_A(K8_SA(0, 1), 1, 0);
  if (wr == 1) K8_BAR;
  K8_WV(4); K8_BAR;
  K8_STAGE_B(K8_SB(1, 0), 0, 1); K8_STAGE_A(K8_SA(1, 0), 0, 1); K8_STAGE_B(K8_SB(1, 1), 1, 1);
  K8_WV(6); K8_BAR;
#pragma unroll 1
  for (int t = 0; t < nt - 2; t += 2) {
    K8_LDB(B0, 0, 0); K8_SCHED; K8_LDA(At, 0, 0); K8_STAGE_A(K8_SA(1, 1), 1, t + 1);
    K8_WL(8); K8_BAR; K8_WL(0); K8_MMA(0, 0, At, B0); K8_BAR; K8_SCHED;
    K8_LDB(B1, 0, 1); K8_STAGE_B(K8_SB(0, 0), 0, t + 2);
    K8_BAR; K8_WL(0); K8_MMA(0, 1, At, B1); K8_BAR;
    K8_LDA(At, 0, 1); K8_STAGE_A(K8_SA(0, 0), 0, t + 2);
    K8_BAR; K8_WL(0); K8_MMA(1, 0, At, B0); K8_BAR; K8_SCHED;
    K8_STAGE_B(K8_SB(0, 1), 1, t + 2);
    K8_WV(6); K8_BAR; K8_MMA(1, 1, At, B1); K8_BAR;
    K8_LDB(B0, 1, 0); K8_SCHED; K8_LDA(At, 1, 0); K8_STAGE_A(K8_SA(0, 1), 1, t + 2);
    K8_WL(8); K8_BAR; K8_WL(0); K8_MMA(0, 0, At, B0); K8_BAR; K8_SCHED;
    K8_LDB(B1, 1, 1); K8_STAGE_B(K8_SB(1, 0), 0, t + 3);
    K8_BAR; K8_WL(0); K8_MMA(0, 1, At, B1); K8_BAR;
    K8_LDA(At, 1, 1); K8_STAGE_A(K8_SA(1, 0), 0, t + 3);
    K8_BAR; K8_WL(0); K8_MMA(1, 0, At, B0); K8_BAR; K8_SCHED;
    K8_STAGE_B(K8_SB(1, 1), 1, t + 3);
    K8_WV(6); K8_BAR; K8_MMA(1, 1, At, B1); K8_BAR;
  }
  { K8_LDB(B0, 0, 0); K8_LDA(At, 0, 0); K8_STAGE_A(K8_SA(1, 1), 1, nt - 1);
    K8_BAR; K8_WL(0); K8_MMA(0, 0, At, B0); K8_BAR;
    K8_LDB(B1, 0, 1); K8_BAR; K8_WL(0); K8_MMA(0, 1, At, B1); K8_BAR;
    K8_LDA(At, 0, 1); K8_WV(4); K8_BAR; K8_WL(0); K8_MMA(1, 0, At, B0); K8_MMA(1, 1, At, B1); K8_BAR; }
  { K8_LDB(B0, 1, 0); K8_LDA(At, 1, 0); K8_WV(2); K8_BAR; K8_WL(0); K8_MMA(0, 0, At, B0); K8_BAR;
    K8_LDB(B1, 1, 1); K8_WV(0); K8_BAR; K8_WL(0); K8_MMA(0, 1, At, B1); K8_BAR;
    K8_LDA(At, 1, 1); K8_BAR; K8_WL(0); K8_MMA(1, 0, At, B0); K8_MMA(1, 1, At, B1); K8_BAR; }
  if (wr == 0) K8_BAR;
}
DI void k8_tile_end() { asm volatile("s_waitcnt vmcnt(0) lgkmcnt(0)" ::: "memory"); __syncthreads(); }

template <int MF>
DI void zero_acc(f32x4 (&acc)[MF][4]) {
#pragma unroll
  for (int m = 0; m < MF; ++m)
#pragma unroll
    for (int n = 0; n < 4; ++n) acc[m][n] = (f32x4){0.f, 0.f, 0.f, 0.f};
}
#define XCD_TILE_LOOP(n_mt, n_nt, mt, nt) \
  for (int xcd_ = bid & 7, cnt_ = ((n_nt) - xcd_ + 7) >> 3, q_ = bid >> 3, mt = 0, nt = 0; \
       q_ < (n_mt) * cnt_ && (mt = q_ / cnt_, nt = xcd_ + 8 * (q_ % cnt_), true); q_ += nblk >> 3)
#define TILE_LOOP(n_mt, n_nt, mt, nt) \
  for (int t_ = bid >> 3, mt = 0, nt = 0; t_ < (((n_mt) + 7) >> 3) * (n_nt) && (mt = (t_ / (n_nt)) * 8 + (bid & 7), nt = t_ % (n_nt), true); t_ += nblk >> 3) \
    if (mt < (n_mt))
struct RowsDense { const bf16_t* base; int ld; DI const bf16_t* operator()(int r) const { return base + (size_t)r * ld; } DI unsigned off(int r) const { return (unsigned)r * (unsigned)ld; } static constexpr bool kDense = true; };


template <int MF, class RowPtr>
DI void store_tile_bf16(const f32x4 (&v)[MF][4], char* smem, int wid, int lane, RowPtr dst) {
  char* W = smem + GSTAGE + wid * 8192;
  const int fr = lane & 15, fq = lane >> 4;
#pragma unroll
  for (int hm = 0; hm < MF / 4; ++hm) {
#pragma unroll
    for (int m = 0; m < 4; ++m)
#pragma unroll
      for (int n = 0; n < 4; ++n) {
        const int row = m * 16 + fr, c16 = 2 * n + (fq >> 1);
        u32x2 o; o[0] = pack2(v[hm * 4 + m][n][0], v[hm * 4 + m][n][1]); o[1] = pack2(v[hm * 4 + m][n][2], v[hm * 4 + m][n][3]);
        *(u32x2*)(W + row * 128 + ((c16 ^ (row & 7)) << 4) + (fq & 1) * 8) = o;
      }
    asm volatile("s_waitcnt lgkmcnt(0)" ::: "memory");
#pragma unroll
    for (int it = 0; it < 8; ++it) {
      const int row = it * 8 + (lane >> 3), c16 = lane & 7;
      const u32x4 d = *(const u32x4*)(W + row * 128 + ((c16 ^ (row & 7)) << 4));
      *(u32x4*)(dst(hm * 64 + row) + c16 * 8) = d;
    }
    asm volatile("s_waitcnt lgkmcnt(0)" ::: "memory");
  }
}

template <int MF, class RowPtr>
DI void store_tile_bf16_32(const f32x4 (&v)[MF][2], char* smem, int wid, int lane, RowPtr dst) {
  char* W = smem + GSTAGE + wid * 8192;
  const int fr = lane & 15, fq = lane >> 4;
#pragma unroll
  for (int hm = 0; hm < MF / 4; ++hm) {
#pragma unroll
    for (int m = 0; m < 4; ++m)
#pragma unroll
      for (int n = 0; n < 2; ++n) {
        const int row = m * 16 + fr, c16 = 2 * n + (fq >> 1);
        u32x2 o; o[0] = pack2(v[hm * 4 + m][n][0], v[hm * 4 + m][n][1]); o[1] = pack2(v[hm * 4 + m][n][2], v[hm * 4 + m][n][3]);
        *(u32x2*)(W + row * 64 + ((c16 ^ ((row >> 1) & 3)) << 4) + (fq & 1) * 8) = o;
      }
    asm volatile("s_waitcnt lgkmcnt(0)" ::: "memory");
#pragma unroll
    for (int it = 0; it < 4; ++it) {
      const int row = it * 16 + (lane >> 2), c16 = lane & 3;
      const u32x4 d = *(const u32x4*)(W + row * 64 + ((c16 ^ ((row >> 1) & 3)) << 4));
      *(u32x4*)(dst(hm * 64 + row) + c16 * 8) = d;
    }
    asm volatile("s_waitcnt lgkmcnt(0)" ::: "memory");
  }
}

template <int MF, class RowPtr>
DI void store_tile_u8(const f32x4 (&v)[MF][4], char* smem, int wid, int lane, RowPtr dst) {
  char* W = smem + GSTAGE + wid * 8192;
  const int fr = lane & 15, fq = lane >> 4;
#pragma unroll
  for (int hm = 0; hm < MF / 4; ++hm) {
#pragma unroll
    for (int m = 0; m < 4; ++m)
#pragma unroll
      for (int n = 0; n < 4; ++n) {
        const int row = m * 16 + fr;
        const f32x4 q = v[hm * 4 + m][n] * 255.f + 0.5f;
        const unsigned o = (unsigned)q[0] | ((unsigned)q[1] << 8) | ((unsigned)q[2] << 16) | ((unsigned)q[3] << 24);
        *(unsigned*)(W + row * 64 + ((n ^ ((row >> 1) & 3)) << 4) + fq * 4) = o;
      }
    asm volatile("s_waitcnt lgkmcnt(0)" ::: "memory");
#pragma unroll
    for (int it = 0; it < 4; ++it) {
      const int row = it * 16 + (lane >> 2), c16 = lane & 3;
      const u32x4 d = *(const u32x4*)(W + row * 64 + ((c16 ^ ((row >> 1) & 3)) << 4));
      *(u32x4*)(dst(hm * 64 + row) + c16 * 16) = d;
    }
    asm volatile("s_waitcnt lgkmcnt(0)" ::: "memory");
  }
}

template <int MF>
DI void store_tile_vt(const f32x4 (&v)[MF][4], char* smem, int wid, int lane, bf16_t* vt0) {
  char* W = smem + GSTAGE + wid * 8192;
  const int fr = lane & 15, fq = lane >> 4;
#pragma unroll
  for (int hm = 0; hm < MF / 4; ++hm) {
#pragma unroll
    for (int m = 0; m < 4; ++m) {
      const int trow = m * 16 + fr, pos = (trow & ~31) + perm32(trow & 31);
#pragma unroll
      for (int n = 0; n < 4; ++n)
#pragma unroll
        for (int j = 0; j < 4; ++j) {
          const int dim = n * 16 + fq * 4 + j;
          *(bf16_t*)(W + dim * 128 + (((pos >> 3) ^ (dim & 7)) << 4) + (pos & 7) * 2) = (bf16_t)(pack2(v[hm * 4 + m][n][j], 0.f) & 0xffffu);
        }
    }
    asm volatile("s_waitcnt lgkmcnt(0)" ::: "memory");
#pragma unroll
    for (int it = 0; it < 8; ++it) {
      const int dim = it * 8 + (lane >> 3), c16 = lane & 7;
      const u32x4 d = *(const u32x4*)(W + dim * 128 + ((c16 ^ (dim & 7)) << 4));
      *(u32x4*)(vt0 + (size_t)dim * 4096 + hm * 64 + c16 * 8) = d;
    }
    asm volatile("s_waitcnt lgkmcnt(0)" ::: "memory");
  }
}

DI void phase_inproj(const Params& p, int layer, int bid, int nblk, char* smem) {
  char* wsq = opqp(p.ws);
  const bf16_t* hb = (const bf16_t*)(wsq + OFF_HB);
  const bf16_t* wt = (const bf16_t*)(wsq + OFF_WIN) + (size_t)layer * 6912 * 1024;
  constexpr int NTN = PW / 256;
  TILE_LOOP(NT / 256, NTN, mt, nt) {
    f32x4 acc[8][4]; zero_acc(acc);
    gemm_kloop8(acc, RowsDense{hb + (size_t)mt * 256 * DM, DM}, wt + (size_t)nt * 256 * DM, DM, DM, smem);
    const int t2 = tidx(), lane = t2 & 63, wid = t2 >> 6, wr = wid >> 2, wc = wid & 3, fr = lane & 15, fq = lane >> 4;
    char* ws2 = opqp(wsq);
    bf16_t* P = (bf16_t*)(ws2 + OFF_P); bf16_t* VT = (bf16_t*)(ws2 + OFF_VT);
    float* LOGF = (float*)(ws2 + OFF_LOGF); float* IW = (float*)(ws2 + OFF_IW);
    const int unit = nt * 4 + wc;
    int gsel = -1; float scale = 1.f; int vh = -1;
    if (unit < 4) { gsel = 0; scale = QS_SWA; } else if (unit < 6) gsel = 1;
    else if (unit < 8) vh = unit - 6;
    else if (unit < 12) { gsel = 2; scale = QS_FOX; } else if (unit < 16) gsel = 3;
    else if (unit < 20) vh = 2 + unit - 16;
    else if (unit < 24) scale = QS_SB;
    else if (unit >= 28 && unit < 32) vh = 6 + unit - 28;
    else if (unit >= 32 && unit < 36) { gsel = 4; scale = QS_DSA; } else if (unit == 36) gsel = 5;
    else if (unit == 37) vh = 10;
    else if (unit >= 38 && unit < 42) scale = 0.125f;
    const float* gain = p.qk_gain + (size_t)layer * 384 + (gsel < 0 ? 0 : gsel) * 64;
    if (unit == U_SM) {
#pragma unroll
      for (int m = 0; m < 8; ++m) {
        const int tok = mt * 256 + wr * 128 + m * 16 + fr;
        if (fq == 0) {
          f32x4 v = acc[m][0]; f32x4 o;
#pragma unroll
          for (int j = 0; j < 4; ++j) o[j] = log_sigmoid_f(v[j] + p.forget_bias[layer * 4 + j]);
          *(f32x4*)(LOGF + (size_t)tok * 4) = o;
        } else if (fq == 1) {
          f32x4 v = acc[m][0];
          *(f32x4*)(IW + (size_t)tok * 4) = v * 0.5f;
        }
      }
    } else {
#pragma unroll
      for (int m = 0; m < 8; ++m) {
        float r = 1.f;
        if (gsel >= 0) {
          float ss = 0.f;
#pragma unroll
          for (int n = 0; n < 4; ++n)
#pragma unroll
            for (int j = 0; j < 4; ++j) ss += acc[m][n][j] * acc[m][n][j];
          ss += __shfl_xor(ss, 16); ss += __shfl_xor(ss, 32);
          r = rsqrtf(ss * (1.f / 64.f) + 1e-6f);
        }
#pragma unroll
        for (int n = 0; n < 4; ++n) {
          f32x4 v = acc[m][n];
          if (gsel >= 0) { f32x4 gg = *(const f32x4*)(gain + n * 16 + fq * 4); v = v * r * gg; }
          acc[m][n] = v * scale;
        }
      }
      const int ln = lane, tok0 = mt * 256 + wr * 128;
      if (vh >= 0) {
        store_tile_vt<8>(acc, smem, wid, ln, VT + (((size_t)(tok0 >> 12) * 11 + vh) * 64) * 4096 + (tok0 & 4095));
      } else {
        bf16_t* pb = P + (size_t)tok0 * PW + unit * 64;
        store_tile_bf16<8>(acc, smem, wid, ln, [&](int row) { return pb + (size_t)row * PW; });
      }
    }
    k8_tile_end();
  }
}

DI void phase_cumsum(const Params& p, int bid, int nblk) {
  char* wsq = opqp(p.ws);
  const float* LOGF = (const float*)(wsq + OFF_LOGF); float* CT = (float*)(wsq + OFF_CT);
  const int lane = tidx() & 63, wid = tidx() >> 6;
  for (int seq = bid * NWV + wid; seq < 32; seq += nblk * NWV) {
    const int b = seq >> 2, h = seq & 3;
    float tot = 0.f;
    for (int i = 0; i < 64; ++i) tot += LOGF[((size_t)b * 4096 + lane * 64 + i) * 4 + h];
    float incl = tot;
    for (int o = 1; o < 64; o <<= 1) { float t = __shfl_up(incl, o); if (lane >= o) incl += t; }
    float run = incl - tot;
    for (int i = 0; i < 64; ++i) { run += LOGF[((size_t)b * 4096 + lane * 64 + i) * 4 + h]; const int sidx = lane * 64 + i; CT[((size_t)b * 4 + h) * 4096 + (sidx & ~31) + perm32(sidx & 31)] = run * LOG2E; }
  }
}

typedef float f32x16 __attribute__((ext_vector_type(16)));
#define MFMA32(a, b, c) __builtin_amdgcn_mfma_f32_32x32x16_bf16((a), (b), (c), 0, 0, 0)
#define CROW(i, h) (((i) & 3) + 8 * ((i) >> 2) + 4 * (h))
DI size_t sc_row_off(int b, int t) { const int i = t >> 5; return (size_t)b * SC_PER_B + 1024UL * ((size_t)i * (i + 1) / 2) + (size_t)(t & 31) * (size_t)((i + 1) * 32); }
DI f32x16 zero16() { f32x16 z;
#pragma unroll
  for (int i = 0; i < 16; ++i) z[i] = 0.f; return z; }
DI bf16x8 pack_step(const f32x16& x, int s) {
  u32x4 v; v[0] = pack2(x[8 * s], x[8 * s + 1]); v[1] = pack2(x[8 * s + 2], x[8 * s + 3]); v[2] = pack2(x[8 * s + 4], x[8 * s + 5]); v[3] = pack2(x[8 * s + 6], x[8 * s + 7]);
  return __builtin_bit_cast(bf16x8, v);
}
DI void load_qf(bf16x8 (&qf)[4], const bf16_t* qp) {
#pragma unroll
  for (int ks = 0; ks < 4; ++ks) qf[ks] = *(const bf16x8*)(qp + 16 * ks);
}
DI void store_ot(bf16_t* op, const f32x16 (&o)[2], float scale, int h) {
#pragma unroll
  for (int db = 0; db < 2; ++db)
#pragma unroll
    for (int g = 0; g < 4; ++g) {
      u32x2 w; w[0] = pack2(o[db][4 * g] * scale, o[db][4 * g + 1] * scale); w[1] = pack2(o[db][4 * g + 2] * scale, o[db][4 * g + 3] * scale);
      *(u32x2*)(op + 32 * db + 8 * g + 4 * h) = w;
    }
}
DI void glds16(const void* g, void* l) { __builtin_amdgcn_global_load_lds((const void __attribute__((address_space(1)))*)g, (lds_ptr_t)l, 16, 0, 0); }
DI bf16x8 lds_frag(const char* base, int row, int chunk) { return *(const bf16x8*)(base + row * 128 + ((chunk ^ ((row >> 1) & 7)) << 4)); }

DI f32x16 qk_tile(const bf16_t* kp, const bf16x8 (&qf)[4]) {
  f32x16 acc = zero16();
#pragma unroll
  for (int ks = 0; ks < 4; ++ks) { bf16x8 kf = *(const bf16x8*)(kp + 16 * ks); acc = MFMA32(kf, qf[ks], acc); }
  return acc;
}
DI void pv_tile(f32x16 (&o)[2], const bf16_t* vp, const f32x16& pacc) {
#pragma unroll
  for (int s = 0; s < 2; ++s) {
    const bf16x8 pb = pack_step(pacc, s);
#pragma unroll
    for (int db = 0; db < 2; ++db) { const bf16x8 vf = *(const bf16x8*)(vp + (size_t)db * 32 * 4096 + 8 * s); o[db] = MFMA32(vf, pb, o[db]); }
  }
}
DI void fast_swa(const Params& p, int layer, int b, int hq, int qt, int lane, const float* tb  ) {
  const bf16_t* P = (const bf16_t*)(p.ws + OFF_P); bf16_t* O = (bf16_t*)(p.ws + OFF_O);
  const int kv = hq >> 1;
  const bf16_t* vt = (const bf16_t*)(p.ws + OFF_VT) + ((size_t)b * 11 + kv) * 64 * 4096;
  const int r = lane & 31, h = lane >> 5, q0 = qt * 32;
  bf16x8 qf[4]; load_qf(qf, P + (size_t)(b * 4096 + q0 + r) * PW + (U_AQ + hq) * 64 + 8 * h);
  f32x16 o[2]; o[0] = zero16(); o[1] = zero16();
  float m = p.attn_sinks[layer * 4 + hq] * LOG2E, l = (h == 0) ? 1.f : 0.f;
  const bf16_t* kbase = P + (size_t)(b * 4096 + r) * PW + (U_AK + kv) * 64 + 8 * h;
  const bf16_t* vbase = vt + (size_t)r * 4096 + 16 * h;
  for (int kb = (qt >= 4 ? qt - 4 : 0); kb <= qt; ++kb) {
    const int key0 = kb * 32;
    f32x16 s = qk_tile(kbase + (size_t)key0 * PW, qf);
#pragma unroll
    for (int i = 0; i < 16; ++i) {
      const int dist = q0 + r - key0 - CROW(i, h);
      const bool ok = dist >= 0 && dist < 128;
      s[i] = ok ? s[i] + tb[hq * 128 + (dist & 127)] : -INFINITY;
    }
    float ml = s[0];
#pragma unroll
    for (int i = 1; i < 16; ++i) ml = fmaxf(ml, s[i]);
    ml = fmaxf(ml, __shfl_xor(ml, 32));
    const float mn = fmaxf(m, ml);
    const float alpha = __builtin_amdgcn_exp2f(m - mn);
    float ps = 0.f;
#pragma unroll
    for (int i = 0; i < 16; ++i) { s[i] = __builtin_amdgcn_exp2f(s[i] - mn); ps += s[i]; }
    l = l * alpha + ps; m = mn;
#pragma unroll
    for (int i = 0; i < 16; ++i) { o[0][i] *= alpha; o[1][i] *= alpha; }
    pv_tile(o, vbase + key0, s);
  }
  l += __shfl_xor(l, 32);
  store_ot(O + (size_t)(b * 4096 + q0 + r) * 1024 + hq * 64, o, 1.f / l, h);
}

constexpr int ABUF = 16384 + 2048, RING = 4;
struct KVStream {
  const bf16_t* kg; const bf16_t* vg; const float* cg; int tid;
  DI void stage(char* smem, int buf, int j) const {
    char* B = smem + buf * ABUF;
    glds16(kg + (size_t)64 * j * PW, B + tid * 16);
    glds16(vg + 64 * j, B + 8192 + tid * 16);
    if (cg) { if ((tid & 63) < 2) glds16(cg + 64 * j, B + 16384 + ((tid >> 6) * 2 + (tid & 63)) * 16); }
  }
};
DI KVStream make_stream(const bf16_t* krow0  , const bf16_t* vt  , const float* c  , int tid) {
  const int srow = tid >> 3, sch = tid & 7, fs = (srow >> 1) & 7;
  KVStream st; st.tid = tid;
  st.kg = krow0 + (size_t)srow * PW + ((sch ^ fs) << 3);
  st.vg = vt + (size_t)srow * 4096 + ((sch ^ fs) << 3);
  st.cg = c ? c + 4 * ((tid >> 6) * 2 + (tid & 63)) : nullptr;
  return st;
}
template <int NL> DI void ring_wait_barrier(int ahead) {
  if (NL == 3) { if (ahead >= 2) asm volatile("s_waitcnt vmcnt(6)" ::: "memory"); else if (ahead == 1) asm volatile("s_waitcnt vmcnt(3)" ::: "memory"); else asm volatile("s_waitcnt vmcnt(0)" ::: "memory"); }
  else { if (ahead >= 2) asm volatile("s_waitcnt vmcnt(4)" ::: "memory"); else if (ahead == 1) asm volatile("s_waitcnt vmcnt(2)" ::: "memory"); else asm volatile("s_waitcnt vmcnt(0)" ::: "memory"); }
  asm volatile("s_waitcnt lgkmcnt(0)" ::: "memory");
  __builtin_amdgcn_s_barrier();
  asm volatile("" ::: "memory");
}
DI f32x16 qk_lds(const char* KB, int u, int r, int h, const bf16x8 (&qf)[4]) {
  f32x16 acc = zero16();
#pragma unroll
  for (int ks = 0; ks < 4; ++ks) acc = MFMA32(lds_frag(KB, 32 * u + r, 2 * ks + h), qf[ks], acc);
  return acc;
}
DI void pv_lds(f32x16 (&o)[2], const char* VB, int u, int r, int h, const f32x16& pacc) {
#pragma unroll
  for (int s = 0; s < 2; ++s) {
    const bf16x8 pb = pack_step(pacc, s);
#pragma unroll
    for (int db = 0; db < 2; ++db) o[db] = MFMA32(lds_frag(VB, 32 * db + r, 4 * u + 2 * h + s), pb, o[db]);
  }
}
DI float max3f(float a, float b, float c) { float r; asm("v_max3_f32 %0, %1, %2, %3" : "=v"(r) : "v"(a), "v"(b), "v"(c)); return r; }
DI void pk_sub_scalar(f32x16& s, float m) {
  const f32x2 mm = {m, m};
#pragma unroll
  for (int i = 0; i < 8; ++i) {
    f32x2 t = {s[2 * i], s[2 * i + 1]}, r;
    asm("v_pk_add_f32 %0, %1, %2 neg_lo:[0,1] neg_hi:[0,1]" : "=v"(r) : "v"(t), "v"(mm));
    s[2 * i] = r[0]; s[2 * i + 1] = r[1];
  }
}
DI float pk_sum(const f32x16& s) {
  f32x2 a = {s[0], s[1]}, b = {s[2], s[3]};
#pragma unroll
  for (int i = 2; i < 8; i += 2) { a = a + (f32x2){s[2 * i], s[2 * i + 1]}; b = b + (f32x2){s[2 * i + 2], s[2 * i + 3]}; }
  a = a + b; return a[0] + a[1];
}
DI void online_softmax(f32x16& s, float& m, float& l, f32x16 (&o)[2]) {
  float ml = max3f(s[0], s[1], s[2]);
#pragma unroll
  for (int i = 3; i < 15; i += 2) ml = max3f(ml, s[i], s[i + 1]);
  ml = max3f(ml, s[15], __shfl_xor(max3f(ml, s[15], s[15]), 32));
  if (__builtin_expect(__ballot(ml > m + 8.f) != 0ULL, 0)) {
    const float mn = fmaxf(m, ml);
    const float ms = (mn == -INFINITY) ? 0.f : mn;
    const float alpha = __builtin_amdgcn_exp2f(m - ms);
    l *= alpha; m = mn;
    const f32x2 aa = {alpha, alpha};
#pragma unroll
    for (int i = 0; i < 8; ++i) {
      f32x2 t0 = {o[0][2 * i], o[0][2 * i + 1]}, t1 = {o[1][2 * i], o[1][2 * i + 1]};
      t0 = t0 * aa; t1 = t1 * aa; o[0][2 * i] = t0[0]; o[0][2 * i + 1] = t0[1]; o[1][2 * i] = t1[0]; o[1][2 * i + 1] = t1[1];
    }
  }
  pk_sub_scalar(s, (m == -INFINITY) ? 0.f : m);
#pragma unroll
  for (int i = 0; i < 16; ++i) s[i] = __builtin_amdgcn_exp2f(s[i]);
  l += pk_sum(s);
}


DI void qk_lds2(f32x16& s0, f32x16& s1, const char* KB, int r, int h, const bf16x8 (&qf)[4]) {
  bf16x8 k0[4], k1[4];
#pragma unroll
  for (int ks = 0; ks < 4; ++ks) { k0[ks] = lds_frag(KB, r, 2 * ks + h); k1[ks] = lds_frag(KB, 32 + r, 2 * ks + h); }
  s0 = zero16(); s1 = zero16();
#pragma unroll
  for (int ks = 0; ks < 4; ++ks) { s0 = MFMA32(k0[ks], qf[ks], s0); s1 = MFMA32(k1[ks], qf[ks], s1); }
}
DI void ld_vfrags(bf16x8 (&vf)[2][2][2], const char* VB, int r, int h) {
#pragma unroll
  for (int u = 0; u < 2; ++u)
#pragma unroll
    for (int db = 0; db < 2; ++db)
#pragma unroll
      for (int sx = 0; sx < 2; ++sx) vf[u][db][sx] = lds_frag(VB, 32 * db + r, 4 * u + 2 * h + sx);
}
DI void pv2(f32x16 (&o)[2], const bf16x8 (&vf)[2][2][2], const f32x16& p0, const f32x16& p1) {
#pragma unroll
  for (int sx = 0; sx < 2; ++sx) {
    const bf16x8 pb0 = pack_step(p0, sx), pb1 = pack_step(p1, sx);
#pragma unroll
    for (int db = 0; db < 2; ++db) { o[db] = MFMA32(vf[0][db][sx], pb0, o[db]); o[db] = MFMA32(vf[1][db][sx], pb1, o[db]); }
  }
}
DI void online_softmax2(f32x16& s0, f32x16& s1, float& m, float& l, f32x16 (&o)[2]) {
  float ml = max3f(s0[0], s0[1], s1[0]);
#pragma unroll
  for (int i = 1; i < 15; i += 2) { ml = max3f(ml, s0[i + 1], s0[i + 2 > 15 ? 15 : i + 2]); ml = max3f(ml, s1[i], s1[i + 1]); }
  ml = max3f(ml, s1[15], s0[15]);
  ml = fmaxf(ml, __shfl_xor(ml, 32));
  if (__builtin_expect(__ballot(ml > m + 8.f) != 0ULL, 0)) {
    const float mn = fmaxf(m, ml);
    const float ms = (mn == -INFINITY) ? 0.f : mn;
    const float alpha = __builtin_amdgcn_exp2f(m - ms);
    l *= alpha; m = mn;
    const f32x2 aa = {alpha, alpha};
#pragma unroll
    for (int i = 0; i < 8; ++i) {
      f32x2 t0 = {o[0][2 * i], o[0][2 * i + 1]}, t1 = {o[1][2 * i], o[1][2 * i + 1]};
      t0 = t0 * aa; t1 = t1 * aa; o[0][2 * i] = t0[0]; o[0][2 * i + 1] = t0[1]; o[1][2 * i] = t1[0]; o[1][2 * i + 1] = t1[1];
    }
  }
  const float mr = (m == -INFINITY) ? 0.f : m;
  pk_sub_scalar(s0, mr); pk_sub_scalar(s1, mr);
#pragma unroll
  for (int i = 0; i < 16; ++i) { s0[i] = __builtin_amdgcn_exp2f(s0[i]); s1[i] = __builtin_amdgcn_exp2f(s1[i]); }
  l += pk_sum(s0) + pk_sum(s1);
}

DI void fox_block(const Params& p, int b, int hd, int qb, char* smem) {
  char* wsq = opqp(p.ws);
  const bf16_t* P = (const bf16_t*)(wsq + OFF_P); bf16_t* O = (bf16_t*)(wsq + OFF_O);
  const int tid = tidx(), lane = tid & 63, wid = __builtin_amdgcn_readfirstlane(tid >> 6), r = lane & 31, h = lane >> 5;
  const int q0 = qb * 256 + 32 * wid, ntile = qb * 4 + 4, jmax = (q0 + 31) >> 6;
  const KVStream st = make_stream(P + (size_t)b * 4096 * PW + (U_FK + hd) * 64, (const bf16_t*)(wsq + OFF_VT) + ((size_t)b * 11 + 2 + hd) * 64 * 4096,
                                  (const float*)(wsq + OFF_CT) + ((size_t)b * 4 + hd) * 4096, tid);
  bf16x8 qf[4]; load_qf(qf, P + (size_t)(b * 4096 + q0 + r) * PW + (U_FQ + hd) * 64 + 8 * h);
  asm volatile("" :: "v"(qf[0]), "v"(qf[1]), "v"(qf[2]), "v"(qf[3]));
  f32x16 o[2]; o[0] = zero16(); o[1] = zero16();
  float m = -INFINITY, l = 0.f;
  __syncthreads();
#pragma unroll 1
  for (int j = 0; j < RING - 1 && j < ntile; ++j) st.stage(smem, j, j);
  ring_wait_barrier<3>((ntile - 1 < RING - 2 ? ntile - 1 : RING - 2));
#pragma unroll 1
  for (int j = 0; j < ntile; ++j) {
    if (j + RING - 1 < ntile) st.stage(smem, (j + RING - 1) & (RING - 1), j + RING - 1);
    if (j <= jmax) {
      const char* B = smem + (j & (RING - 1)) * ABUF;
      f32x16 s0, s1;
      qk_lds2(s0, s1, B, r, h, qf);
      bf16x8 vf[2][2][2]; ld_vfrags(vf, B + 8192, r, h);
#pragma unroll
      for (int g = 0; g < 4; ++g) {
        const f32x4 ca = *(const f32x4*)(B + 16384 + (16 * h + 4 * g) * 4), cb = *(const f32x4*)(B + 16384 + (32 + 16 * h + 4 * g) * 4);
        f32x2 t0 = {s0[4 * g], s0[4 * g + 1]}, t1 = {s0[4 * g + 2], s0[4 * g + 3]}, t2 = {s1[4 * g], s1[4 * g + 1]}, t3 = {s1[4 * g + 2], s1[4 * g + 3]};
        t0 = t0 - (f32x2){ca[0], ca[1]}; t1 = t1 - (f32x2){ca[2], ca[3]}; t2 = t2 - (f32x2){cb[0], cb[1]}; t3 = t3 - (f32x2){cb[2], cb[3]};
        s0[4 * g] = t0[0]; s0[4 * g + 1] = t0[1]; s0[4 * g + 2] = t1[0]; s0[4 * g + 3] = t1[1];
        s1[4 * g] = t2[0]; s1[4 * g + 1] = t2[1]; s1[4 * g + 2] = t3[0]; s1[4 * g + 3] = t3[1];
      }
      if (__builtin_expect(64 * j + 63 > q0, 0)) {
#pragma unroll
        for (int i = 0; i < 16; ++i) {
          if (64 * j + CROW(i, h) > q0 + r) s0[i] = -INFINITY;
          if (64 * j + 32 + CROW(i, h) > q0 + r) s1[i] = -INFINITY;
        }
        asm volatile("" ::: "memory");
      }
      online_softmax2(s0, s1, m, l, o);
      pv2(o, vf, s0, s1);
    }
    if (j + 1 < ntile) ring_wait_barrier<3>((ntile - 1 < j + RING - 1 ? ntile - 1 : j + RING - 1) - (j + 1));
  }
  l += __shfl_xor(l, 32);
  store_ot(O + (size_t)(b * 4096 + q0 + r) * 1024 + 256 + hd * 64, o, 1.f / l, h);
}

DI void sb_block(const Params& p, int b, int hd, int qb, char* smem) {
  char* wsq = opqp(p.ws);
  const bf16_t* P = (const bf16_t*)(wsq + OFF_P); bf16_t* O = (bf16_t*)(wsq + OFF_O);
  const int tid = tidx(), lane = tid & 63, wid = __builtin_amdgcn_readfirstlane(tid >> 6), r = lane & 31, h = lane >> 5;
  const int q0 = qb * 256 + 32 * wid, ntile = qb * 4 + 4, jmax = (q0 + 31) >> 6;
  const KVStream st = make_stream(P + (size_t)b * 4096 * PW + (U_SK + hd) * 64, (const bf16_t*)(wsq + OFF_VT) + ((size_t)b * 11 + 6 + hd) * 64 * 4096, nullptr, tid);
  bf16x8 qf[4]; load_qf(qf, P + (size_t)(b * 4096 + q0 + r) * PW + (U_SQ + hd) * 64 + 8 * h);
  asm volatile("" :: "v"(qf[0]), "v"(qf[1]), "v"(qf[2]), "v"(qf[3]));
  f32x16 o[2]; o[0] = zero16(); o[1] = zero16();
  float R = 0.f;
  volatile int* flg = (volatile int*)(smem + RING * ABUF);
  __syncthreads();
#pragma unroll 1
  for (int it = 0; it < RING - 1 && it < ntile; ++it) st.stage(smem, it, ntile - 1 - it);
  ring_wait_barrier<2>((ntile - 1 < RING - 2 ? ntile - 1 : RING - 2));
#pragma unroll 1
  for (int it = 0; it < ntile; ++it) {
    const int j = ntile - 1 - it;
    if (it + RING - 1 < ntile) st.stage(smem, (it + RING - 1) & (RING - 1), j - (RING - 1));
    const bool wdone = __ballot(R >= -160.f) == 0ULL;
    if (j <= jmax && !wdone) {
      const char* B = smem + (it & (RING - 1)) * ABUF;
#pragma unroll
      for (int uu = 0; uu < 2; ++uu) {
        const int u = 1 - uu, key0 = 64 * j + 32 * u;
        if (key0 <= q0) {
          const bool diag = key0 == q0;
          f32x16 z = qk_lds(B, u, r, h, qf);
          f32x16 lk;
#pragma unroll
          for (int i = 0; i < 16; ++i) {
            const float t = __builtin_amdgcn_exp2f(-fabsf(z[i]));
            lk[i] = -(fmaxf(z[i], 0.f) + __builtin_amdgcn_logf(1.f + t));
          }
          if (diag) {
#pragma unroll
            for (int i = 0; i < 16; ++i) if (CROW(i, h) >= r) lk[i] = 0.f;
          }
          float gs[4], ps[4];
#pragma unroll
          for (int g = 0; g < 4; ++g) { gs[g] = (lk[4 * g] + lk[4 * g + 1]) + (lk[4 * g + 2] + lk[4 * g + 3]); ps[g] = __shfl_xor(gs[g], 32); }
          float run = R;
          f32x16 a;
#pragma unroll
          for (int g = 3; g >= 0; --g) {
            float later = run + (h == 0 ? ps[g] : 0.f);
#pragma unroll
            for (int jj = 3; jj >= 0; --jj) { const int i = 4 * g + jj; a[i] = __builtin_amdgcn_exp2f(z[i] + lk[i] + later); later += lk[i]; }
            run += gs[g] + ps[g];
          }
          R = run;
          if (diag) {
#pragma unroll
            for (int i = 0; i < 16; ++i) if (CROW(i, h) >= r) a[i] = 0.f;
          }
          pv_lds(o, B + 8192, u, r, h, a);
        }
      }
    }
    if (it + 1 < ntile) {
      if (lane == 0) flg[(it & 1) * 8 + wid] = (__ballot(R >= -160.f) == 0ULL) ? 1 : 0;
      ring_wait_barrier<2>((ntile - 1 < it + RING - 1 ? ntile - 1 : it + RING - 1) - (it + 1));
      int alld = 1;
#pragma unroll
      for (int w = 0; w < 8; ++w) alld &= flg[(it & 1) * 8 + w];
      if (alld) { asm volatile("s_waitcnt vmcnt(0)" ::: "memory"); break; }
    }
  }
  store_ot(O + (size_t)(b * 4096 + q0 + r) * 1024 + 512 + hd * 64, o, 1.f, h);
}


DI void swa_block(const Params& p, int layer, int b, int kv, int qb, char* smem, const float* tb  ) {
  char* wsq = opqp(p.ws);
  const bf16_t* P = (const bf16_t*)(wsq + OFF_P); bf16_t* O = (bf16_t*)(wsq + OFF_O);
  const int tid = tidx(), lane = tid & 63, wid = __builtin_amdgcn_readfirstlane(tid >> 6), r = lane & 31, h = lane >> 5;
  const int q0 = qb * 256 + 32 * wid, jlo = qb > 0 ? qb * 4 - 2 : 0, ntile = qb * 4 + 4 - jlo;
  const KVStream st = make_stream(P + (size_t)b * 4096 * PW + (U_AK + kv) * 64, (const bf16_t*)(wsq + OFF_VT) + ((size_t)b * 11 + kv) * 64 * 4096, nullptr, tid);
  bf16x8 qf[2][4];
#pragma unroll
  for (int g = 0; g < 2; ++g) load_qf(qf[g], P + (size_t)(b * 4096 + q0 + r) * PW + (U_AQ + 2 * kv + g) * 64 + 8 * h);
  asm volatile("" :: "v"(qf[0][0]), "v"(qf[0][1]), "v"(qf[0][2]), "v"(qf[0][3]), "v"(qf[1][0]), "v"(qf[1][1]), "v"(qf[1][2]), "v"(qf[1][3]));
  f32x16 o[2][2];
  float m[2], l[2];
#pragma unroll
  for (int g = 0; g < 2; ++g) { o[g][0] = zero16(); o[g][1] = zero16(); m[g] = p.attn_sinks[layer * 4 + 2 * kv + g] * LOG2E; l[g] = (h == 0) ? 1.f : 0.f; }
  __syncthreads();
#pragma unroll 1
  for (int it = 0; it < RING - 1 && it < ntile; ++it) st.stage(smem, it, jlo + it);
  ring_wait_barrier<2>((ntile - 1 < RING - 2 ? ntile - 1 : RING - 2));
#pragma unroll 1
  for (int it = 0; it < ntile; ++it) {
    const int j = jlo + it;
    if (it + RING - 1 < ntile) st.stage(smem, (it + RING - 1) & (RING - 1), j + RING - 1);
    const char* B = smem + (it & (RING - 1)) * ABUF;
#pragma unroll
    for (int u = 0; u < 2; ++u) {
      const int key0 = 64 * j + 32 * u;
      if (key0 <= q0 && key0 + 128 >= q0) {
        const bool edge = (key0 == q0) || (key0 + 128 == q0);
#pragma unroll
        for (int g = 0; g < 2; ++g) {
          f32x16 s = qk_lds(B, u, r, h, qf[g]);
          const float* tbh = tb + (2 * kv + g) * 128;
#pragma unroll
          for (int i = 0; i < 16; ++i) {
            const int dist = q0 + r - key0 - CROW(i, h);
            s[i] += tbh[dist & 127];
            if (edge && (dist < 0 || dist >= 128)) s[i] = -INFINITY;
          }
          online_softmax(s, m[g], l[g], o[g]);
          pv_lds(o[g], B + 8192, u, r, h, s);
        }
      }
    }
    if (it + 1 < ntile) ring_wait_barrier<2>((ntile - 1 < it + RING - 1 ? ntile - 1 : it + RING - 1) - (it + 1));
  }
#pragma unroll
  for (int g = 0; g < 2; ++g) {
    const float lt = l[g] + __shfl_xor(l[g], 32);
    store_ot(O + (size_t)(b * 4096 + q0 + r) * 1024 + (2 * kv + g) * 64, o[g], 1.f / lt, h);
  }
}

DI void dsa_block(const Params& p, int b, int qb, char* smem, const float* tb  ) {
  char* wsq = opqp(p.ws);
  const bf16_t* P = (const bf16_t*)(wsq + OFF_P); bf16_t* O = (bf16_t*)(wsq + OFF_O);
  const unsigned* MW = (const unsigned*)(wsq + OFF_MASK);
  const int tid = tidx(), lane = tid & 63, wid = __builtin_amdgcn_readfirstlane(tid >> 6), r = lane & 31, h = lane >> 5;
  const int hd = wid & 3, q0 = qb * 64 + 32 * (wid >> 2), ntile = qb + 1;
  const KVStream st = make_stream(P + (size_t)b * 4096 * PW + U_DK * 64, (const bf16_t*)(wsq + OFF_VT) + ((size_t)b * 11 + 10) * 64 * 4096, nullptr, tid);
  bf16x8 qf[4]; load_qf(qf, P + (size_t)(b * 4096 + q0 + r) * PW + (U_DQ + hd) * 64 + 8 * h);
  asm volatile("" :: "v"(qf[0]), "v"(qf[1]), "v"(qf[2]), "v"(qf[3]));
  f32x16 o[2]; o[0] = zero16(); o[1] = zero16();
  float m = -INFINITY, l = 0.f;
  const unsigned* mrow = MW + (size_t)(b * 4096 + q0 + r) * 128 + h;
  const float bfar = tb[hd * 128 + 127];
  auto stage_all = [&](int buf, int j) {
    st.stage(smem, buf, j);
    __builtin_amdgcn_global_load_lds((const void __attribute__((address_space(1)))*)(mrow + 2 * j), (lds_ptr_t)(smem + buf * ABUF + 16384 + wid * 256 + lane * 4), 4, 0, 0);
  };
  __syncthreads();
#pragma unroll 1
  for (int j = 0; j < RING - 1 && j < ntile; ++j) stage_all(j, j);
  ring_wait_barrier<3>((ntile - 1 < RING - 2 ? ntile - 1 : RING - 2));
#pragma unroll 1
  for (int j = 0; j < ntile; ++j) {
    if (j + RING - 1 < ntile) stage_all((j + RING - 1) & (RING - 1), j + RING - 1);
    const char* B = smem + (j & (RING - 1)) * ABUF;
#pragma unroll
    for (int u = 0; u < 2; ++u) {
      const unsigned word = *(const unsigned*)(B + 16384 + wid * 256 + (u * 32 + r) * 4);
      if (__ballot(word != 0u) != 0ULL) {
        const int key0 = 64 * j + 32 * u;
        const unsigned wh = word >> (4 * h);
        f32x16 s = qk_lds(B, u, r, h, qf);
        if (q0 - key0 - 31 >= 113) {
#pragma unroll
          for (int i = 0; i < 16; ++i) s[i] += bfar;
        } else {
#pragma unroll
          for (int i = 0; i < 16; ++i) { int dist = q0 + r - key0 - CROW(i, h); dist = dist < 0 ? 0 : (dist > 127 ? 127 : dist); s[i] += tb[hd * 128 + dist]; }
        }
#pragma unroll
        for (int i = 0; i < 16; ++i) { const int bit = (i & 3) + 8 * (i >> 2); if (!((wh >> bit) & 1u)) s[i] = -INFINITY; }
        online_softmax(s, m, l, o);
        pv_lds(o, B + 8192, u, r, h, s);
      }
    }
    if (j + 1 < ntile) ring_wait_barrier<3>((ntile - 1 < j + RING - 1 ? ntile - 1 : j + RING - 1) - (j + 1));
  }
  l += __shfl_xor(l, 32);
  store_ot(O + (size_t)(b * 4096 + q0 + r) * 1024 + 768 + hd * 64, o, 1.f / l, h);
}

constexpr int IBUF = 32768;
DI void idx_block(const Params& p, int b, int qb, char* smem) {
  char* wsq = opqp(p.ws);
  const bf16_t* P = (const bf16_t*)(wsq + OFF_P); const float* IW = (const float*)(wsq + OFF_IW); float* SC = (float*)(wsq + OFF_R);
  const int tid = tidx(), lane = tid & 63, wid = __builtin_amdgcn_readfirstlane(tid >> 6), r = lane & 31, h = lane >> 5;
  const int kp = wid >> 1, q0 = qb * 64 + 32 * (wid & 1), tok = b * 4096 + q0 + r, nround = (qb >> 2) + 1;
  const int srow = tid >> 3, sch = tid & 7, fs = (srow >> 1) & 7;
  const bf16_t* kg = P + (size_t)(b * 4096 + srow) * PW + U_IK * 64 + ((sch ^ fs) << 3);
  auto stage = [&](int buf, int R) {
    char* B = smem + buf * IBUF;
#pragma unroll
    for (int i = 0; i < 4; ++i) glds16(kg + (size_t)(256 * R + 64 * i) * PW, B + i * 8192 + tid * 16);
  };
  bf16x8 qf[4][4];
#pragma unroll
  for (int hh = 0; hh < 4; ++hh) load_qf(qf[hh], P + (size_t)tok * PW + (U_IQ + hh) * 64 + 8 * h);
  const f32x4 w = *(const f32x4*)(IW + (size_t)tok * 4);
  float* row = SC + sc_row_off(b, q0 + r) + 4 * h;
  stage(0, 0);
  asm volatile("s_waitcnt vmcnt(0)" ::: "memory");
  __syncthreads();
  f32x16 pend[2]; int pkey[2] = {-1, -1};
  auto flush = [&]() {
#pragma unroll
    for (int u = 0; u < 2; ++u) if (pkey[u] >= 0) {
#pragma unroll
      for (int g = 0; g < 4; ++g) { f32x4 v = {pend[u][4 * g], pend[u][4 * g + 1], pend[u][4 * g + 2], pend[u][4 * g + 3]}; *(f32x4*)(row + pkey[u] + 8 * g) = v; }
    }
  };
#pragma unroll 1
  for (int R = 0; R < nround; ++R) {
    if (R + 1 < nround) stage((R + 1) & 1, R + 1);
    flush();
    const char* KB = smem + (R & 1) * IBUF + kp * 8192;
#pragma unroll
    for (int u = 0; u < 2; ++u) {
      const int key0 = 256 * R + 64 * kp + 32 * u;
      pkey[u] = -1;
      if (key0 <= q0) {
        bf16x8 kf[4];
#pragma unroll
        for (int ks = 0; ks < 4; ++ks) kf[ks] = lds_frag(KB, 32 * u + r, 2 * ks + h);
        f32x16 sc = zero16();
#pragma unroll
        for (int hh = 0; hh < 4; ++hh) {
          f32x16 acc = zero16();
#pragma unroll
          for (int ks = 0; ks < 4; ++ks) acc = MFMA32(kf[ks], qf[hh][ks], acc);
#pragma unroll
          for (int i = 0; i < 16; ++i) sc[i] += w[hh] * fmaxf(acc[i], 0.f);
          __builtin_amdgcn_sched_barrier(0);
        }
#pragma unroll
        for (int i = 0; i < 16; ++i) sc[i] += 0.f;
        if (key0 == q0) {
#pragma unroll
          for (int i = 0; i < 16; ++i) if (CROW(i, h) > r) sc[i] = -INFINITY;
        }
        pend[u] = sc; pkey[u] = key0;
      }
    }
    asm volatile("s_waitcnt vmcnt(0)" ::: "memory");
    __syncthreads();
  }
  flush();
}

DI void build_bias_table(const Params& p, float* tb, int hoff) {
  for (int i = tidx(); i < 512; i += NTHR) { const int hd = i >> 7, dist = i & 127; tb[i] = p.t5[T5B[dist] * 8 + hoff + hd] * LOG2E; }
  __syncthreads();
}

DI int wave_sum_i(int v) {
  int tot = 0;
#pragma unroll
  for (int b = 0; b < 7; ++b) tot += __builtin_popcountll(__ballot((v >> b) & 1)) << b;
  return tot;
}
DI float wave_min(float v) { for (int o = 32; o > 0; o >>= 1) v = fminf(v, __shfl_xor(v, o)); return v; }
DI unsigned f2key(float f) { unsigned b = __float_as_uint(f); return (b & 0x80000000u) ? ~b : (b | 0x80000000u); }
DI float key2f(unsigned k) { return __uint_as_float((k & 0x80000000u) ? (k & 0x7fffffffu) : ~k); }
DI void dsa_select2(const Params& p, int item, int lane) {
  char* wsq = opqp(p.ws);
  const float* SC = (const float*)(wsq + OFF_R); u64* MASK = (u64*)(wsq + OFF_MASK);
  const int t = item & 4095, b = item >> 12, tok = b * 4096 + t;
  const float* row = SC + sc_row_off(b, t);
  u64 myword = 0;
  if (t < 256) {
#pragma unroll
    for (int r = 0; r < 4; ++r) { u64 w = __ballot((r * 64 + lane) <= t); if (lane == r) myword = w; }
  } else {
    const int nch = (t >> 10) + 1;
    f32x2 xp[32];
#define XS(r) xp[(r) >> 1][(r) & 1]
#pragma unroll
    for (int c = 0; c < 4; ++c) {
      if (c < nch) {
#pragma unroll
        for (int rr = 0; rr < 16; ++rr) { const int r = c * 16 + rr, s = r * 64 + lane; XS(r) = (s <= t) ? row[s] : -INFINITY; }
      } else {
#pragma unroll
        for (int rr = 0; rr < 16; ++rr) XS(c * 16 + rr) = -INFINITY;
      }
    }
    auto count_ge = [&](float v) -> int {
      const f32x2 vv = {v, v};
      int lt = 0;
#pragma unroll
      for (int c = 0; c < 4; ++c) if (c < nch) {
#pragma unroll
        for (int q = 0; q < 8; ++q) {
          f32x2 d;
          asm("v_pk_add_f32 %0, %1, %2 neg_lo:[0,1] neg_hi:[0,1]" : "=v"(d) : "v"(xp[c * 8 + q]), "v"(vv));
          lt += (int)(__float_as_uint(d[0]) >> 31) + (int)(__float_as_uint(d[1]) >> 31);
        }
      }
      return nch * 1024 - (wave_sum_i(lt & 127) + ((__builtin_popcountll(__ballot(lt >> 7))) << 7));
    };
    float mx = -INFINITY, mn = INFINITY;
#pragma unroll
    for (int c = 0; c < 4; ++c) if (c < nch) {
#pragma unroll
      for (int rr = 0; rr < 16; ++rr) { const float v = XS(c * 16 + rr); mx = fmaxf(mx, v); mn = fminf(mn, v == -INFINITY ? INFINITY : v); }
    }
    mx = wave_max(mx); mn = wave_min(mn);
    float T = mx; bool exact = false;
    int chi = count_ge(mx);
    if (chi < 256) {
      float lo = mn, hi = mx; int clo = t + 1;
      if (lo < 0.f && hi > 0.f) { const int c0 = count_ge(0.f); if (c0 >= 256) { lo = 0.f; clo = c0; } else { hi = 0.f; chi = c0; } }
      float glo = __builtin_amdgcn_logf((float)clo + 0.5f) - 8.0028150f, ghi = __builtin_amdgcn_logf((float)chi + 0.5f) - 8.0028150f;
      int side = 0; bool conv = false;
      for (int it = 0; it < 40; ++it) {
        if (clo == 256) { T = lo; exact = true; break; }
        const float frac = fminf(fmaxf(glo / (glo - ghi), 0.01f), 0.99f);
        float mid = lo + (hi - lo) * frac;
        if (!(mid > lo && mid < hi)) { mid = lo + (hi - lo) * 0.5f; if (!(mid > lo && mid < hi)) { conv = true; break; } }
        const int c = count_ge(mid);
        if (c == 256) { T = mid; exact = true; break; }
        const float gm = __builtin_amdgcn_logf((float)c + 0.5f) - 8.0028150f;
        if (c > 256) { lo = mid; clo = c; glo = gm; if (side == 1) ghi *= 0.5f; side = 1; }
        else { hi = mid; chi = c; ghi = gm; if (side == -1) glo *= 0.5f; side = -1; }
      }
      if (!exact) {
        if (!conv) {
          unsigned klo = f2key(lo), khi = f2key(hi);
          while (khi - klo > 1u) {
            const unsigned km = klo + ((khi - klo) >> 1);
            const int c = count_ge(key2f(km));
            if (c == 256) { klo = km; exact = true; break; }
            if (c > 256) klo = km; else khi = km;
          }
          lo = key2f(klo);
        }
        T = lo;
      }
    }
    int need = 4096;
    if (!exact) {
      int cgt = 0;
#pragma unroll
      for (int c = 0; c < 4; ++c) if (c < nch) {
#pragma unroll
        for (int rr = 0; rr < 16; ++rr) cgt += (XS(c * 16 + rr) > T) ? 1 : 0;
      }
      need = 256 - wave_sum_i(cgt);
    }
    if (exact) {
#pragma unroll
      for (int c = 0; c < 4; ++c) if (c < nch) {
#pragma unroll
        for (int rr = 0; rr < 16; ++rr) { const int r = c * 16 + rr; const u64 w = __ballot(XS(r) >= T); if (lane == r) myword = w; }
      }
    } else
#pragma unroll
    for (int c = 0; c < 4; ++c) if (c < nch) {
#pragma unroll
      for (int rr = 0; rr < 16; ++rr) {
        const int r = c * 16 + rr;
        const u64 gt = __ballot(exact ? (XS(r) >= T) : (XS(r) > T));
        u64 eq = __ballot(!exact && XS(r) == T);
        if (eq) {
          int ne = __builtin_popcountll(eq);
          if (ne > need) { int drop = ne - need; while (drop-- > 0) eq &= ~(1ULL << (63 - __builtin_clzll(eq))); ne = need; }
          need -= ne;
        }
        const u64 w = gt | eq;
        if (lane == r) myword = w;
      }
    }
  }
  MASK[(size_t)tok * 64 + lane] = myword;
}

DI void phase_attn1(const Params& p, int layer, int bid, int nblk, char* smem) {
  const int lane = tidx() & 63, wid = __builtin_amdgcn_readfirstlane(tidx() >> 6), gw = bid * NWV + wid, nw = nblk * NWV;
  phase_cumsum(p, bid, nblk);
  for (int pr = bid; pr < 256; pr += nblk) { const int bh = pr & 31, i = pr >> 5;
#pragma unroll 1
    for (int k = 0; k < 2; ++k) sb_block(p, bh >> 2, bh & 3, k ? i : 15 - i, smem); }
  for (int pr = bid; pr < 256; pr += nblk) { const int b = pr & 7, i = pr >> 3;
#pragma unroll 1
    for (int k = 0; k < 2; ++k) idx_block(p, b, k ? i : 63 - i, smem); }
  { float* tb = (float*)(smem + RING * ABUF + 64); __syncthreads(); build_bias_table(p, tb, 0);
    for (int it = bid; it < 256; it += nblk) swa_block(p, layer, it & 7, (it >> 3) & 1, it >> 4, smem, tb);
    __syncthreads(); }
}
DI void phase_attn2(const Params& p, int layer, int bid, int nblk, char* smem) {
  const int lane = tidx() & 63, wid = __builtin_amdgcn_readfirstlane(tidx() >> 6), gw = bid * NWV + wid, nw = nblk * NWV;
  for (int pr = bid; pr < 256; pr += nblk) { const int bh = pr & 31, i = pr >> 5;
#pragma unroll 1
    for (int k = 0; k < 2; ++k) fox_block(p, bh >> 2, bh & 3, k ? i : 15 - i, smem); }
  for (int it = gw; it < NB * SEQ / 2; it += nw) {
    const int b = it >> 11, t0 = it & 2047;
#pragma unroll 1
    for (int k = 0; k < 2; ++k) dsa_select2(p, b * 4096 + (k ? 4095 - t0 : t0), lane);
  }
}
DI void phase_attn3(const Params& p, int layer, int bid, int nblk, char* smem) {
  float* tb = (float*)(smem + RING * ABUF); build_bias_table(p, tb, 4);
  for (int pr = bid; pr < 256; pr += nblk) { const int b = pr & 7, i = pr >> 3;
#pragma unroll 1
    for (int k = 0; k < 2; ++k) dsa_block(p, b, k ? i : 63 - i, smem, tb); }
  __syncthreads();
}

DI void phase_gates(const Params& p, int layer, int bid, int nblk, char* smem) {
  char* wsq = opqp(p.ws);
  const bf16_t* hb = (const bf16_t*)(wsq + OFF_HB);
  const bf16_t* wt = (const bf16_t*)(wsq + OFF_WIN) + ((size_t)layer * 6912 + PW) * 1024;
  TILE_LOOP(128, 16, mt, nt) {
    f32x4 acc[8][4]; zero_acc(acc);
#if K8_GATES
    gemm_kloop8(acc, RowsDense{hb + (size_t)mt * 256 * DM, DM}, wt + (size_t)nt * 256 * DM, DM, DM, smem);
#else
    gemm_kloop<8>(acc, RowsDense{hb + (size_t)mt * 256 * DM, DM}, wt + (size_t)nt * 256 * DM, DM, DM, smem);
#endif
#pragma unroll
    for (int m = 0; m < 8; ++m)
#pragma unroll
      for (int n = 0; n < 4; ++n)
#pragma unroll
        for (int j = 0; j < 4; ++j) acc[m][n][j] = sigmoid_fast(acc[m][n][j]);
    const int t2 = tidx(), ln = t2 & 63, wid2 = t2 >> 6;
    unsigned char* G = (unsigned char*)(opqp(wsq) + OFF_R);
    unsigned char* gb = G + (size_t)(mt * 256 + (wid2 >> 2) * 128) * 4096 + nt * 256 + (wid2 & 3) * 64;
    store_tile_u8<8>(acc, smem, wid2, ln, [&](int row) { return gb + (size_t)row * 4096; });
#if K8_GATES
    k8_tile_end();
#endif
  }
}

DI void phase_merge(const Params& p, int layer, int bid, int nblk, char* smem) {
  char* wsq = opqp(p.ws);
  const bf16_t* O = (const bf16_t*)(wsq + OFF_O); const unsigned char* G = (const unsigned char*)(wsq + OFF_R);
  const bf16_t* wt = (const bf16_t*)(wsq + OFF_WBR) + (size_t)layer * 1024 * 1024;
  bf16_t* MG = (bf16_t*)(wsq + OFF_MG);
  constexpr int MST = 24576, MRING = 4;
  TILE_LOOP(256, 4, mt, nt) {
    const int tid = tidx(), wid = tid >> 6, lane = tid & 63, wr = wid >> 2, wc = wid & 3, fr = lane & 15, fq = lane >> 4;
    const int srow = tid >> 2, sg = ((srow >> 3) & 1) * 3, sch = (tid & 3) ^ sg;
    const bf16_t* asrc = O + (size_t)(mt * 128 + srow) * 1024 + sch * 8;
    const bf16_t* bsrc0 = wt + (size_t)(nt * 256 + srow) * 1024 + sch * 8;
    const bf16_t* bsrc1 = bsrc0 + (size_t)128 * 1024;
    auto stage = [&](int buf, int ks) {
      char* B = smem + buf * MST;
      glds16(asrc + ks * 32, B + tid * 16);
      glds16(bsrc0 + ks * 32, B + 8192 + tid * 16);
      glds16(bsrc1 + ks * 32, B + 16384 + tid * 16);
    };
    int aoff[4], boff[4];
#pragma unroll
    for (int m = 0; m < 4; ++m) { const int r = wr * 64 + m * 16 + fr; aoff[m] = r * 64 + ((fq ^ (((r >> 3) & 1) * 3)) << 4); }
#pragma unroll
    for (int n = 0; n < 4; ++n) { const int r = wc * 64 + n * 16 + fr; boff[n] = 8192 + r * 64 + ((fq ^ (((r >> 3) & 1) * 3)) << 4); }
    f32x4 macc[4][4]; zero_acc(macc);
    f32x4 acc[4][4]; zero_acc(acc);
    __syncthreads();
    stage(0, 0); stage(1, 1); stage(2, 2);
    ring_wait_barrier<3>(2);
#pragma unroll 1
    for (int ks = 0; ks < 32; ++ks) {
      if (ks + 3 < 32) stage((ks + 3) & (MRING - 1), ks + 3);
      const char* B = smem + (ks & (MRING - 1)) * MST;
      bf16x8 af[4], bfr[4];
#pragma unroll
      for (int n = 0; n < 4; ++n) bfr[n] = *(const bf16x8*)(B + boff[n]);
#pragma unroll
      for (int m = 0; m < 4; ++m) af[m] = *(const bf16x8*)(B + aoff[m]);
#pragma unroll
      for (int m = 0; m < 4; ++m)
#pragma unroll
        for (int n = 0; n < 4; ++n) acc[m][n] = __builtin_amdgcn_mfma_f32_16x16x32_bf16(bfr[n], af[m], acc[m][n], 0, 0, 0);
      if ((ks & 7) == 7) {
        const int b = ks >> 3;
        const unsigned char* gp = G + (size_t)(mt * 128 + wr * 64 + fr) * 4096 + b * 1024 + nt * 256 + wc * 64 + fq * 4;
        unsigned gv[4][4];
#pragma unroll
        for (int m = 0; m < 4; ++m)
#pragma unroll
          for (int n = 0; n < 4; ++n) gv[m][n] = *(const unsigned*)(gp + (size_t)m * 16 * 4096 + n * 16);
        __builtin_amdgcn_sched_barrier(0);
#pragma unroll
        for (int m = 0; m < 4; ++m)
#pragma unroll
          for (int n = 0; n < 4; ++n) {
            const unsigned g = gv[m][n];
            macc[m][n][0] += ((float)(g & 255u) * (1.f / 255.f)) * acc[m][n][0];
            macc[m][n][1] += ((float)((g >> 8) & 255u) * (1.f / 255.f)) * acc[m][n][1];
            macc[m][n][2] += ((float)((g >> 16) & 255u) * (1.f / 255.f)) * acc[m][n][2];
            macc[m][n][3] += ((float)(g >> 24) * (1.f / 255.f)) * acc[m][n][3];
            acc[m][n] = (f32x4){0.f, 0.f, 0.f, 0.f};
          }
      }
      if (ks + 1 < 32) ring_wait_barrier<3>((31 < ks + 3 ? 31 : ks + 3) - (ks + 1));
    }
    __syncthreads();
    {
      bf16_t* mb = MG + (size_t)(mt * 128 + wr * 64) * 1024 + nt * 256 + wc * 64;
      store_tile_bf16<4>(macc, smem, wid, lane, [&](int row) { return mb + (size_t)row * 1024; });
    }
  }
}

DI void phase_outproj(const Params& p, int layer, int bid, int nblk, char* smem) {
  char* wsq = opqp(p.ws);
  const bf16_t* MG = (const bf16_t*)(wsq + OFF_MG);
  const bf16_t* wt = (const bf16_t*)(wsq + OFF_WOUT) + (size_t)layer * 1024 * 1024;
  TILE_LOOP(128, 4, mt, nt) {
    f32x4 acc[8][4]; zero_acc(acc);
    gemm_kloop8(acc, RowsDense{MG + (size_t)mt * 256 * 1024, 1024}, wt + (size_t)nt * 256 * 1024, 1024, 1024, smem);
    const int t2 = tidx(), lane2 = t2 & 63, wid2 = t2 >> 6, wr = wid2 >> 2, wc = wid2 & 3, fr = lane2 & 15, fq = lane2 >> 4;
    float* out2 = opqp(p.out); const float* xin2 = layer == 0 ? opqp(p.x) : out2;
#pragma unroll
    for (int m = 0; m < 8; ++m) {
      const int tok = mt * 256 + wr * 128 + m * 16 + fr;
#pragma unroll
      for (int n = 0; n < 4; ++n) {
        const int col = nt * 256 + wc * 64 + n * 16 + fq * 4;
        f32x4 xv = *(const f32x4*)(xin2 + (size_t)tok * 1024 + col);
        *(f32x4*)(out2 + (size_t)tok * 1024 + col) = xv + acc[m][n];
      }
      __builtin_amdgcn_sched_barrier(0);
    }
    k8_tile_end();
  }
}

DI void phase_router2(const Params& p, int layer, int bid, int nblk, char* smem) {
  char* wsq = opqp(p.ws);
  const int lane = tidx() & 63, wid = __builtin_amdgcn_readfirstlane(tidx() >> 6), grp64 = wid >> 2, kw = wid & 3;
  phase_norm(p.out, p.norm_ffn_g + (size_t)layer * DM, (bf16_t*)(wsq + OFF_HB), bid, nblk);
  float* part = (float*)smem + grp64 * (4 * 37 * 64);
  int* TOKE = (int*)(wsq + OFF_TOKE); float* TOKG = (float*)(wsq + OFF_TOKG); int* TCNT = (int*)(wsq + OFF_TCNT);
  int* lcnt = (int*)(smem + 2 * 4 * 37 * 64 * 4);
  typedef const __attribute__((address_space(4))) float cfloat;
  cfloat* g = (cfloat*)(p.norm_ffn_g + (size_t)layer * DM + kw * 256);
  const float* wrg = p.w_rg + (size_t)layer * DM * 4; const float* wre = p.w_re + (size_t)layer * DM * 32;
  const int tid_ = tidx();
  for (int tile = bid; tile < NT / 128; tile += nblk) {
    const int tok = tile * 128 + grp64 * 64 + lane;
    const float* xr = p.out + (size_t)tok * DM + kw * 256;
    float acc[36]; float ss = 0.f;
#pragma unroll
    for (int e = 0; e < 36; ++e) acc[e] = 0.f;
#pragma unroll 1
    for (int hf = 0; hf < 2; ++hf) {
      __syncthreads();
#pragma unroll
      for (int i = 0; i < 9; ++i) {
        const int c = tid_ + 512 * i, kq = c / 1152, rem = c % 1152, k = rem / 9, j = rem % 9;
        const int kk = kq * 256 + hf * 128 + k;
        const float* src = (j < 8) ? (wre + (size_t)kk * 32 + 4 * j) : (wrg + (size_t)kk * 4);
        glds16(src, smem + c * 16);
      }
      asm volatile("s_waitcnt vmcnt(0)" ::: "memory");
      __syncthreads();
      const float* wimg = (const float*)smem + kw * 128 * 36;
#pragma unroll 1
      for (int k4 = 0; k4 < 128; k4 += 4) {
        const f32x4 xv = *(const f32x4*)(xr + hf * 128 + k4);
#pragma unroll
        for (int j = 0; j < 4; ++j) {
          const int k = k4 + j; const float x = xv[j]; ss += x * x; const float xg = x * g[hf * 128 + k];
          const float* wk = wimg + k * 36;
#pragma unroll
          for (int e4 = 0; e4 < 9; ++e4) {
            const f32x4 w = *(const f32x4*)(wk + 4 * e4);
#pragma unroll
            for (int e = 0; e < 4; ++e) acc[4 * e4 + e] += xg * w[e];
          }
        }
      }
    }
    __syncthreads();
    if (tidx() < 32) lcnt[tidx()] = 0;
#pragma unroll
    for (int e = 0; e < 36; ++e) part[(kw * 37 + e) * 64 + lane] = acc[e];
    part[(kw * 37 + 36) * 64 + lane] = ss;
    __syncthreads();
    if (kw == 0) {
      float lg[36];
#pragma unroll
      for (int e = 0; e < 36; ++e) lg[e] = (part[e * 64 + lane] + part[(37 + e) * 64 + lane]) + (part[(74 + e) * 64 + lane] + part[(111 + e) * 64 + lane]);
      const float sst = (part[36 * 64 + lane] + part[(37 + 36) * 64 + lane]) + (part[(74 + 36) * 64 + lane] + part[(111 + 36) * 64 + lane]);
      const float r = rsqrtf(sst * (1.f / DM) + 1e-6f);
#pragma unroll
      for (int e = 0; e < 32; ++e) lg[e] = lg[e] * r + p.b_re[layer * 32 + e];
#pragma unroll
      for (int e = 0; e < 4; ++e) lg[32 + e] = lg[32 + e] * r + p.b_rg[layer * 4 + e];
      int grp = 0; float gm = lg[32];
#pragma unroll
      for (int e = 1; e < 4; ++e) if (lg[32 + e] > gm) { gm = lg[32 + e]; grp = e; }
      float gs = 0.f;
#pragma unroll
      for (int e = 0; e < 4; ++e) gs += expf(lg[32 + e] - gm);
      const float p_grp = 1.f / gs;
      float ei[8];
#pragma unroll
      for (int j = 0; j < 8; ++j) ei[j] = grp == 0 ? lg[j] : (grp == 1 ? lg[8 + j] : (grp == 2 ? lg[16 + j] : lg[24 + j]));
      float em = ei[0];
#pragma unroll
      for (int j = 1; j < 8; ++j) em = fmaxf(em, ei[j]);
      float pe[8]; float es = 0.f;
#pragma unroll
      for (int j = 0; j < 8; ++j) { pe[j] = expf(ei[j] - em); es += pe[j]; }
#pragma unroll
      for (int j = 0; j < 8; ++j) pe[j] = pe[j] / es;
      int i0 = 0; float p0 = pe[0];
#pragma unroll
      for (int j = 1; j < 8; ++j) if (pe[j] > p0) { p0 = pe[j]; i0 = j; }
      int i1 = -1; float p1 = -1.f;
#pragma unroll
      for (int j = 0; j < 8; ++j) if (j != i0 && pe[j] > p1) { p1 = pe[j]; i1 = j; }
      const float den = p0 + p1;
      const int e0 = grp * 8 + i0, e1 = grp * 8 + i1;
      const int r0 = atomicAdd(&lcnt[e0], 1), r1 = atomicAdd(&lcnt[e1], 1);
      TOKE[tok * 2] = e0 | (r0 << 8); TOKE[tok * 2 + 1] = e1 | (r1 << 8);
      TOKG[tok * 2] = p_grp * p0 / den; TOKG[tok * 2 + 1] = p_grp * p1 / den;
    }
    __syncthreads();
    if (tidx() < 32) TCNT[tile * 32 + tidx()] = lcnt[tidx()];
  }
}

DI void load_expert_table(const Params& p, int layer, int* tab) {
  char* wsq = opqp(p.ws);
  const int* CNT = (const int*)(wsq + OFF_CNT) + layer * 64;
  if (tidx() == 0) {
    int acc = 0;
    for (int e = 0; e < 32; ++e) { int c = CNT[e]; int pad = (c + 255) / 256 * 256; tab[e] = acc; acc += pad; tab[32 + e] = acc; tab[64 + e] = c; }
  }
  __syncthreads();
}
DI void phase_slots(const Params& p, int layer, int bid, int nblk, char* smem) {
  char* wsq = opqp(p.ws);
  const int* TOKE = (const int*)(wsq + OFF_TOKE); const float* TOKG = (const float*)(wsq + OFF_TOKG); const int* TCNT = (const int*)(wsq + OFF_TCNT);
  int* CNT = (int*)(wsq + OFF_CNT) + layer * 64; int* SLT = (int*)(wsq + OFF_SLT); float* SLG = (float*)(wsq + OFF_SLG); int* TPOS = (int*)(wsq + OFF_TPOS);
  int* pre = (int*)smem;
  int* pst = pre + 256 * 32;
  const int t = tidx();
  for (int i = t; i < 256 * 32; i += NTHR) pre[i] = TCNT[i];
  __syncthreads();
  if (t < 32) { int run = 0; for (int tl = 0; tl < 256; ++tl) { const int c = pre[tl * 32 + t]; pre[tl * 32 + t] = run; run += c; } pst[32 + t] = run; }
  __syncthreads();
  if (t == 0) { int acc = 0; for (int e = 0; e < 32; ++e) { const int c = pst[32 + e]; pst[e] = acc; acc += (c + 255) / 256 * 256; } }
  __syncthreads();
  if (bid == 0 && t < 32) CNT[t] = pst[32 + t];
  for (int a = bid * NTHR + t; a < 2 * NT; a += nblk * NTHR) {
    const int v = TOKE[a], e = v & 255, rk = v >> 8, tile = a >> 8;
    const int pos = pst[e] + pre[tile * 32 + e] + rk;
    SLT[pos] = a >> 1; SLG[pos] = TOKG[a]; TPOS[a] = pos;
  }
  __syncthreads();
}

struct RowsGather { const bf16_t* base; const int* slt; int slot0; int nvalid; DI const bf16_t* operator()(int r) const { int tok = (r < nvalid) ? slt[slot0 + r] : 0; return base + (size_t)tok * DM; } DI unsigned off(int r) const { int tok = (r < nvalid) ? slt[slot0 + r] : 0; return (unsigned)tok * (unsigned)DM; } static constexpr bool kDense = false; };
DI void phase_up(const Params& p, int layer, int bid, int nblk, char* smem) {
  char* wsq = opqp(p.ws);
  int* tab = (int*)(smem + 2 * GSTAGE); load_expert_table(p, layer, tab);
  const bf16_t* hb = (const bf16_t*)(wsq + OFF_HB); const int* SLT = (const int*)(wsq + OFF_SLT);
  const bf16_t* wt = (const bf16_t*)(wsq + OFF_UP) + (size_t)layer * 32 * 1024 * 1024;
  const int ntiles_m = tab[63] / 256;
  TILE_LOOP(ntiles_m, 4, mt, nt) {
    const int slot0 = mt * 256;
    int e = 0;
    for (int k = 0; k < 32; ++k) if (slot0 >= tab[32 + k]) e = k + 1;
    const int nvalid = tab[e] + tab[64 + e] - slot0;
    f32x4 acc[8][4]; zero_acc(acc);
#if K8_UP
    gemm_kloop8(acc, RowsGather{hb, SLT, slot0, nvalid}, wt + ((size_t)e * 1024 + nt * 256) * 1024, 1024, 1024, smem);
#else
    gemm_kloop<8>(acc, RowsGather{hb, SLT, slot0, nvalid}, wt + ((size_t)e * 1024 + nt * 256) * 1024, 1024, 1024, smem);
#endif
    const int t2 = tidx(), lane = t2 & 63, wid = t2 >> 6, wr = wid >> 2, wc = wid & 3;
    bf16_t* ACT = (bf16_t*)(opqp(wsq) + OFF_ACT);
    f32x4 av[8][2];
#pragma unroll
    for (int m = 0; m < 8; ++m)
#pragma unroll
      for (int n2 = 0; n2 < 2; ++n2) {
        const f32x4 gv = acc[m][2 * n2], uv = acc[m][2 * n2 + 1];
#pragma unroll
        for (int j = 0; j < 4; ++j) av[m][n2][j] = gv[j] * sigmoid_fast(gv[j]) * uv[j];
      }
    {
      const int ln = opq(lane);
      bf16_t* ab = ACT + (size_t)(slot0 + wr * 128) * EFF + nt * 128 + wc * 32;
      store_tile_bf16_32<8>(av, smem, wid, ln, [&](int row) { return ab + (size_t)row * EFF; });
    }
    k8_tile_end();
  }
  __syncthreads();
}
DI void phase_down(const Params& p, int layer, int bid, int nblk, char* smem) {
  char* wsq = opqp(p.ws);
  int* tab = (int*)(smem + 2 * GSTAGE); load_expert_table(p, layer, tab);
  const bf16_t* ACT = (const bf16_t*)(wsq + OFF_ACT);
  const bf16_t* wt = (const bf16_t*)(wsq + OFF_DOWN) + (size_t)layer * 32 * 1024 * 512;
  const int ntiles_m = tab[63] / 256;
  TILE_LOOP(ntiles_m, 4, mt, nt) {
    const int slot0 = mt * 256;
    int e = 0;
    for (int k = 0; k < 32; ++k) if (slot0 >= tab[32 + k]) e = k + 1;
    f32x4 acc[8][4]; zero_acc(acc);
    gemm_kloop8(acc, RowsDense{ACT + (size_t)slot0 * EFF, EFF}, wt + ((size_t)e * 1024 + nt * 256) * 512, 512, 512, smem);
    const int t2 = tidx(), lane = t2 & 63, wid = t2 >> 6, wr = wid >> 2, wc = wid & 3;
    bf16_t* Y = (bf16_t*)(opqp(wsq) + OFF_Y);
    {
      const int ln = opq(lane);
      bf16_t* yb = Y + (size_t)(slot0 + wr * 128) * 1024 + nt * 256 + wc * 64;
      store_tile_bf16<8>(acc, smem, wid, ln, [&](int row) { return yb + (size_t)row * 1024; });
    }
    k8_tile_end();
  }
  __syncthreads();
}
DI void phase_combine(const Params& p, int layer, int bid, int nblk) {
  char* wsq = opqp(p.ws);
  const bf16_t* Y = (const bf16_t*)(wsq + OFF_Y); const int* TPOS = (const int*)(wsq + OFF_TPOS); const float* TOKG = (const float*)(wsq + OFF_TOKG);
  bf16_t* hb = (bf16_t*)(wsq + OFF_HB); const float* gn = p.norm_mix_g + DM;
  const int lane = tidx() & 63, wid = tidx() >> 6;
  for (int tok = bid * NWV + wid; tok < NT; tok += nblk * NWV) {
    const int p0 = TPOS[tok * 2], p1 = TPOS[tok * 2 + 1]; const float g0 = TOKG[tok * 2], g1 = TOKG[tok * 2 + 1];
    f32x4 xo[4]; float ss = 0.f;
#pragma unroll
    for (int i = 0; i < 4; ++i) {
      const int c = lane * 4 + 256 * i;
      f32x4 xv = *(const f32x4*)(p.out + (size_t)tok * DM + c);
      const u32x2 a = *(const u32x2*)(Y + (size_t)p0 * DM + c), bq = *(const u32x2*)(Y + (size_t)p1 * DM + c);
      f32x4 y0 = {__uint_as_float(a[0] << 16), __uint_as_float(a[0] & 0xffff0000u), __uint_as_float(a[1] << 16), __uint_as_float(a[1] & 0xffff0000u)};
      f32x4 y1 = {__uint_as_float(bq[0] << 16), __uint_as_float(bq[0] & 0xffff0000u), __uint_as_float(bq[1] << 16), __uint_as_float(bq[1] & 0xffff0000u)};
      xo[i] = xv + (y0 * g0 + y1 * g1);
      *(f32x4*)(p.out + (size_t)tok * DM + c) = xo[i];
      ss += xo[i][0] * xo[i][0] + xo[i][1] * xo[i][1] + xo[i][2] * xo[i][2] + xo[i][3] * xo[i][3];
    }
    if (layer == 0) {
      ss = wave_sum(ss);
      const float r = rsqrtf(ss * (1.f / DM) + 1e-6f);
#pragma unroll
      for (int i = 0; i < 4; ++i) {
        const f32x4 gg = *(const f32x4*)(gn + lane * 4 + 256 * i);
        u32x2 o; o[0] = pack2(xo[i][0] * r * gg[0], xo[i][1] * r * gg[1]); o[1] = pack2(xo[i][2] * r * gg[2], xo[i][3] * r * gg[3]);
        *(u32x2*)(hb + (size_t)tok * DM + lane * 4 + 256 * i) = o;
      }
    }
  }
}

#define XB_TMO      128
#define XB_XCNT(j)  (256  + 64 * (j))
#define XB_XSUB(j)  (1280 + 64 * (j))
#define XB_XGEN(j)  (2304 + 64 * (j))
#define XB_TOP      3328
#define XB_TOPGEN   3392
#define XCD_BAR_WORDS 3456
#define XB_SPIN_CAP (1u << 20)
#define LAS __attribute__((address_space(3)))
DI unsigned xb_ld(unsigned* p)              { return __hip_atomic_load(p, __ATOMIC_RELAXED, __HIP_MEMORY_SCOPE_AGENT); }
DI unsigned xb_add(unsigned* p, unsigned v) { return __hip_atomic_fetch_add(p, v, __ATOMIC_RELAXED, __HIP_MEMORY_SCOPE_AGENT); }
DI unsigned xb_xcc_id() { return (unsigned)__builtin_amdgcn_s_getreg((3 << 11) | 20) & 0xFu; }
#define XB_SPIN(cond, bar) do { unsigned _sp = 0; while (cond) { __builtin_amdgcn_s_sleep(1); \
    if ((++_sp & 255u) == 0u) { if (xb_ld(&(bar)[XB_TMO])) break; if (_sp > XB_SPIN_CAP) { atomicAdd(&(bar)[XB_TMO], 1u); break; } } } } while (0)
struct XcdBarrier { unsigned* bar; unsigned x; volatile LAS unsigned* st; };
DI XcdBarrier xcd_barrier_post(unsigned* bar, volatile LAS unsigned* st) {
  XcdBarrier b; b.bar = bar; b.x = xb_xcc_id(); b.st = st;
  if (threadIdx.x == 0) (void)xb_add(&bar[XB_XCNT(b.x)], 1u);
  return b;
}
DI void xcd_barrier_complete(unsigned* bar, unsigned x, unsigned& nloc, unsigned& nx) {
  const unsigned G = gridDim.x * gridDim.y * gridDim.z;
  unsigned sum, cnt, mine, sp = 0u;
  for (;;) {
    sum = 0u; cnt = 0u; mine = 0u;
#pragma unroll
    for (unsigned j = 0; j < 16; ++j) { const unsigned c = xb_ld(&bar[XB_XCNT(j)]); sum += c; cnt += (c > 0u) ? 1u : 0u; mine = (j == x) ? c : mine; }
    if (sum == G) break;
    __builtin_amdgcn_s_sleep(1);
    if ((++sp & 255u) == 0u) { if (xb_ld(&bar[XB_TMO])) break; if (sp > XB_SPIN_CAP) { atomicAdd(&bar[XB_TMO], 1u); break; } }
  }
  nloc = mine > 0u ? mine : 1u; nx = cnt > 0u ? cnt : 1u;
}
DI void xcd_barrier(const XcdBarrier& b) {
  asm volatile("s_waitcnt vmcnt(0)" ::: "memory");
  __syncthreads();
  if (threadIdx.x == 0) {
    unsigned* bar = opqp(b.bar);
    __builtin_amdgcn_s_waitcnt(0);
    unsigned nloc = b.st[0], nx = b.st[1];
    if (nloc == 0u) { xcd_barrier_complete(bar, b.x, nloc, nx); b.st[0] = nloc; b.st[1] = nx; }
    const unsigned old = xb_add(&bar[XB_XSUB(b.x)], 1u);
    const unsigned gen = old / nloc;
    if (old + 1u == (gen + 1u) * nloc) {
      __builtin_amdgcn_fence(__ATOMIC_RELEASE, "agent");
      asm volatile("s_waitcnt vmcnt(0)" ::: "memory");
      const unsigned og = xb_add(&bar[XB_TOP], 1u);
      const unsigned tg = og / nx;
      if (og + 1u == (tg + 1u) * nx) xb_add(&bar[XB_TOPGEN], 1u);
      else XB_SPIN(xb_ld(&bar[XB_TOPGEN]) == tg, bar);
      __builtin_amdgcn_fence(__ATOMIC_ACQUIRE, "agent");
      xb_add(&bar[XB_XGEN(b.x)], 1u);
      asm volatile("s_waitcnt vmcnt(0)" ::: "memory");
    } else {
      XB_SPIN(xb_ld(&bar[XB_XGEN(b.x)]) == gen, bar);
      __builtin_amdgcn_fence(__ATOMIC_ACQUIRE, "agent");
      asm volatile("s_waitcnt vmcnt(0)" ::: "memory");
    }
  }
  __syncthreads();
}

namespace cg = cooperative_groups;
__global__ void __launch_bounds__(512, 2) mega(Params p) {
  __shared__ __attribute__((aligned(16))) char smem[2 * GSTAGE + 512];
  cg::grid_group grid = cg::this_grid();
  const int bid = blockIdx.x, nblk = gridDim.x;
  unsigned* bar = (unsigned*)(p.ws + OFF_BAR);
  volatile LAS unsigned* xst = (volatile LAS unsigned*)(smem + 2 * GSTAGE + 448);
  if (bid == 0) for (int i = threadIdx.x; i < XCD_BAR_WORDS; i += NTHR) bar[i] = 0u;
  if (threadIdx.x == 0) { xst[0] = 0u; xst[1] = 0u; }
  for (int rep = 0; rep < 1 + PROBE_CV; ++rep) {
  phase_convert(p, bid, nblk, smem);
  phase_norm(p.x, p.norm_mix_g, (bf16_t*)(p.ws + OFF_HB), bid, nblk);
  grid.sync();
  }
  const XcdBarrier xb = xcd_barrier_post(bar, xst);
#define GS() xcd_barrier(xb)
#pragma unroll 1
  for (int layer = 0; layer < 2; ++layer) {
    for (int rep = 0; rep < 1 + PROBE_GEMM; ++rep) { phase_inproj(p, layer, bid, nblk, smem); GS(); }
    for (int rep = 0; rep < 1 + PROBE_A1; ++rep) { phase_attn1(p, layer, bid, nblk, smem); GS(); }
    for (int rep = 0; rep < 1 + PROBE_A2; ++rep) { phase_attn2(p, layer, bid, nblk, smem); GS(); }
    for (int rep = 0; rep < 1 + PROBE_A3; ++rep) { phase_attn3(p, layer, bid, nblk, smem); GS(); }
    for (int rep = 0; rep < 1 + PROBE_GEMM; ++rep) { phase_gates(p, layer, bid, nblk, smem); GS(); }
    for (int rep = 0; rep < 1 + PROBE_GEMM; ++rep) { phase_merge(p, layer, bid, nblk, smem); GS(); }
    phase_outproj(p, layer, bid, nblk, smem); GS();
    phase_router2(p, layer, bid, nblk, smem); GS();
    phase_slots(p, layer, bid, nblk, smem); GS();
    for (int rep = 0; rep < 1 + PROBE_GEMM; ++rep) { phase_up(p, layer, bid, nblk, smem); GS(); }
    for (int rep = 0; rep < 1 + PROBE_GEMM; ++rep) { phase_down(p, layer, bid, nblk, smem); GS(); }
    phase_combine(p, layer, bid, nblk);
    if (layer == 0) GS();
  }
}

#ifdef PHASE_TEST
template <int PH> __global__ void __launch_bounds__(512, 2) k_phase(Params p, int layer) {
  __shared__ __attribute__((aligned(16))) char smem[2 * GSTAGE + 512];
  const int bid = blockIdx.x, nblk = gridDim.x;
  if (PH == 0) phase_convert(p, bid, nblk, smem);
  if (PH == 1) phase_norm(p.x, p.norm_mix_g, (bf16_t*)(p.ws + OFF_HB), bid, nblk);
  if (PH == 2) phase_inproj(p, layer, bid, nblk, smem);
  if (PH == 3) phase_attn1(p, layer, bid, nblk, smem);
  if (PH == 4) phase_attn2(p, layer, bid, nblk, smem);
  if (PH == 5) phase_attn3(p, layer, bid, nblk, smem);
  if (PH == 6) phase_gates(p, layer, bid, nblk, smem);
  if (PH == 7) phase_merge(p, layer, bid, nblk, smem);
  if (PH == 8) phase_outproj(p, layer, bid, nblk, smem);
  if (PH == 9) phase_router2(p, layer, bid, nblk, smem);
  if (PH == 10) phase_slots(p, layer, bid, nblk, smem);
  if (PH == 11) phase_up(p, layer, bid, nblk, smem);
  if (PH == 12) phase_down(p, layer, bid, nblk, smem);
  if (PH == 13) phase_combine(p, layer, bid, nblk);
  if (PH == 14) sb_block(p, bid & 7, bid & 3, bid & 15, smem);
  if (PH == 15) idx_block(p, bid & 7, bid & 63, smem);
  if (PH == 16) fast_swa(p, layer, bid & 7, bid & 3, bid & 127, tidx() & 63, (float*)smem);
  if (PH == 17) fox_block(p, bid & 7, bid & 3, bid & 15, smem);
  if (PH == 18) dsa_block(p, bid & 7, bid & 63, smem, (float*)smem + 10000);
  if (PH == 19) dsa_select2(p, bid, tidx() & 63);
}
template __global__ void k_phase<14>(Params, int); template __global__ void k_phase<15>(Params, int); template __global__ void k_phase<16>(Params, int);
template __global__ void k_phase<17>(Params, int); template __global__ void k_phase<18>(Params, int); template __global__ void k_phase<19>(Params, int);
template __global__ void k_phase<0>(Params, int); template __global__ void k_phase<1>(Params, int); template __global__ void k_phase<2>(Params, int);
template __global__ void k_phase<3>(Params, int); template __global__ void k_phase<4>(Params, int); template __global__ void k_phase<5>(Params, int);
template __global__ void k_phase<6>(Params, int); template __global__ void k_phase<7>(Params, int); template __global__ void k_phase<8>(Params, int);
template __global__ void k_phase<9>(Params, int); template __global__ void k_phase<10>(Params, int); template __global__ void k_phase<11>(Params, int);
template __global__ void k_phase<12>(Params, int); template __global__ void k_phase<13>(Params, int);
#endif

extern "C" void kernel_launch(void* const* d_in, const int* in_sizes, int n_in, void* d_out, int out_size, void* d_ws, size_t ws_size,
                              hipStream_t stream) {
  Params p{};
  p.x = (const float*)d_in[0]; p.norm_mix_g = (const float*)d_in[1]; p.w_in = (const float*)d_in[2]; p.forget_bias = (const float*)d_in[3];
  p.attn_sinks = (const float*)d_in[4]; p.qk_gain = (const float*)d_in[5]; p.w_branch = (const float*)d_in[6]; p.w_out = (const float*)d_in[7];
  p.t5 = (const float*)d_in[8]; p.norm_ffn_g = (const float*)d_in[9]; p.w_rg = (const float*)d_in[10]; p.b_rg = (const float*)d_in[11];
  p.w_re = (const float*)d_in[12]; p.b_re = (const float*)d_in[13]; p.w_up = (const float*)d_in[14]; p.w_down = (const float*)d_in[15];
  p.out = (float*)d_out; p.ws = (char*)d_ws;
  if (ws_size < WS_END) { fprintf(stderr, "workspace too small: %zu < %zu\n", ws_size, (size_t)WS_END); return; }
  static int grid_blocks = 0;
  if (!grid_blocks) {
    int dev = 0, cus = 0, per_cu = 0;
    hipGetDevice(&dev);
    hipDeviceGetAttribute(&cus, hipDeviceAttributeMultiprocessorCount, dev);
    hipOccupancyMaxActiveBlocksPerMultiprocessor(&per_cu, mega, NTHR, 0);
    if (per_cu > 1) per_cu = 1;
    if (per_cu < 1) per_cu = 1;
    grid_blocks = cus * per_cu;
  }
  void* args[] = {&p};
  hipError_t e = hipLaunchCooperativeKernel((void*)mega, dim3(grid_blocks), dim3(NTHR), args, 0, stream);
  if (e != hipSuccess) fprintf(stderr, "cooperative launch failed: %s (grid %d)\n", hipGetErrorString(e), grid_blocks);
}
```

```cpp
#include <hip/hip_runtime.h>
#include <hip/hip_cooperative_groups.h>
#include <stdint.h>
#include <stdio.h>

typedef unsigned short bf16_t;
typedef short bf16x8 __attribute__((ext_vector_type(8)));
typedef float f32x4 __attribute__((ext_vector_type(4)));
typedef unsigned u32x4 __attribute__((ext_vector_type(4)));
typedef unsigned u32x2 __attribute__((ext_vector_type(2)));
typedef unsigned long long u64;

#define DI __device__ __forceinline__
#ifndef FAST_SWA
#define FAST_SWA 1
#endif
#ifndef FAST_FOX
#define FAST_FOX 1
#endif
#ifndef FAST_SB
#define FAST_SB 1
#endif
#ifndef FAST_DSA
#define FAST_DSA 1
#endif
#ifndef FAST_IDX
#define FAST_IDX 1
#endif
#define PROBE_GEMM 0
#define PROBE_A1 0
#define PROBE_A2 0
#define PROBE_A3 0
#define PROBE_CV 0
#define LOG2E 1.4426950408889634f
#define QS_SWA (FAST_SWA ? 0.125f * LOG2E : 0.125f)
#define QS_FOX (FAST_FOX ? 0.125f * LOG2E : 0.125f)
#define QS_SB (FAST_SB ? 0.125f * LOG2E : 0.125f)
#define QS_DSA (FAST_DSA ? 0.125f * LOG2E : 0.125f)

constexpr int NB = 8, SEQ = 4096, NT = NB * SEQ, DM = 1024;
constexpr int INC = 6856;
constexpr int PW = 2816;
constexpr int NEXP = 32, EFF = 512;
constexpr int NSLOT = 2 * NT + NEXP * 256;
constexpr int NTHR = 512, NWV = 8;
constexpr int U_AQ = 0, U_AK = 4, U_AV = 6, U_FQ = 8, U_FK = 12, U_FV = 16, U_SQ = 20, U_SK = 24, U_SV = 28,
              U_DQ = 32, U_DK = 36, U_DV = 37, U_IQ = 38, U_IK = 42, U_SM = 43;
constexpr long SC_PER_B = 1024L * 8256L;

constexpr size_t AL(size_t x) { return (x + 255) & ~(size_t)255; }
constexpr size_t OFF_WIN = 0;
constexpr size_t OFF_WBR = OFF_WIN + AL(2UL * 6912 * 1024 * 2);
constexpr size_t OFF_WOUT = OFF_WBR + AL(2UL * 4 * 1024 * 256 * 2);
constexpr size_t OFF_UP = OFF_WOUT + AL(2UL * 1024 * 1024 * 2);
constexpr size_t OFF_DOWN = OFF_UP + AL(2UL * 32 * 1024 * 1024 * 2);
constexpr size_t OFF_HB = OFF_DOWN + AL(2UL * 32 * 1024 * 512 * 2);
constexpr size_t OFF_P = OFF_HB + AL((size_t)NT * 1024 * 2);
constexpr size_t OFF_MG = OFF_P;
constexpr size_t OFF_ACT = OFF_P + AL((size_t)NT * 1024 * 2);
constexpr size_t OFF_VT = OFF_P + AL((size_t)NT * PW * 2);
constexpr size_t OFF_LOGF = OFF_VT + AL(8UL * 11 * 64 * 4096 * 2);
constexpr size_t OFF_CT = OFF_LOGF + AL((size_t)NT * 4 * 4);
constexpr size_t OFF_IW = OFF_CT + AL((size_t)NT * 4 * 4);
constexpr size_t OFF_R = OFF_IW + AL((size_t)NT * 4 * 4);
constexpr size_t OFF_Y = OFF_R;
constexpr size_t OFF_O = OFF_R + AL((size_t)NSLOT * 1024 * 4);
constexpr size_t OFF_MASK = OFF_O + AL((size_t)NT * 1024 * 2);
constexpr size_t OFF_TOKE = OFF_MASK + AL((size_t)NT * 512);
constexpr size_t OFF_TOKG = OFF_TOKE + AL((size_t)NT * 8);
constexpr size_t OFF_SLT = OFF_TOKG + AL((size_t)NT * 8);
constexpr size_t OFF_SLG = OFF_SLT + AL((size_t)NSLOT * 4);
constexpr size_t OFF_CNT = OFF_SLG + AL((size_t)NSLOT * 4);
constexpr size_t OFF_TPOS = OFF_CNT + 1024;
constexpr size_t OFF_TCNT = OFF_TPOS + AL((size_t)NT * 8);
constexpr size_t OFF_BAR = OFF_TCNT + AL(256UL * 32 * 4);
constexpr size_t WS_END = OFF_BAR + 16384;
static_assert(8UL * SC_PER_B * 4 <= (size_t)NSLOT * 1024 * 4, "R region");
static_assert(WS_END <= (1UL << 30), "workspace");

struct Params {
  const float* x; const float* norm_mix_g; const float* w_in; const float* forget_bias; const float* attn_sinks;
  const float* qk_gain; const float* w_branch; const float* w_out; const float* t5; const float* norm_ffn_g;
  const float* w_rg; const float* b_rg; const float* w_re; const float* b_re; const float* w_up; const float* w_down;
  float* out; char* ws;
};

DI int opq(int x) { asm volatile("" : "+v"(x)); return x; }
template <class T> DI T* opqp(T* q) { asm volatile("" : "+s"(q)); return q; }
DI int tidx() { int x = __builtin_amdgcn_workitem_id_x(); asm volatile("" : "+v"(x)); return x; }
DI int perm256(int g) { return ((g >> 5) & 3) * 64 + (g >> 7) * 32 + (g & 31); }
DI int perm32(int c) { return ((c >> 2) & 1) * 16 + ((c >> 4) & 1) * 8 + ((c >> 3) & 1) * 4 + (c & 3); }
DI float bf2f(bf16_t v) { return __uint_as_float(((unsigned)v) << 16); }
DI bf16_t f2bf(float f) { unsigned u = __float_as_uint(f); u += 0x7fffu + ((u >> 16) & 1u); return (bf16_t)(u >> 16); }
typedef __bf16 hbf16x2 __attribute__((ext_vector_type(2)));
typedef float f32x2 __attribute__((ext_vector_type(2)));
DI unsigned pack2(float lo, float hi) { f32x2 v = {lo, hi}; return __builtin_bit_cast(unsigned, __builtin_convertvector(v, hbf16x2)); }
DI float wave_sum(float v) { for (int o = 32; o > 0; o >>= 1) v += __shfl_xor(v, o); return v; }
DI float wave_max(float v) { for (int o = 32; o > 0; o >>= 1) v = fmaxf(v, __shfl_xor(v, o)); return v; }
DI float sigmoid_fast(float v) { return __builtin_amdgcn_rcpf(1.f + __builtin_amdgcn_exp2f(-v * 1.4426950408889634f)); }
DI float log_sigmoid_f(float x) { return fminf(x, 0.f) - 0.6931471805599453f * __builtin_amdgcn_logf(1.f + __builtin_amdgcn_exp2f(-fabsf(x) * 1.4426950408889634f)); }

__device__ const unsigned char T5B[128] = {
  0, 1, 2, 3, 4, 5, 6, 7, 8, 9, 10, 11, 12, 13, 14, 15, 16, 16, 16, 17, 17, 18, 18, 18, 19, 19, 19, 20, 20, 20, 20, 21,
  21, 21, 21, 22, 22, 22, 22, 22, 23, 23, 23, 23, 23, 23, 24, 24, 24, 24, 24, 24, 25, 25, 25, 25, 25, 25, 25, 26, 26, 26, 26, 26,
  26, 26, 26, 27, 27, 27, 27, 27, 27, 27, 27, 27, 27, 28, 28, 28, 28, 28, 28, 28, 28, 28, 28, 29, 29, 29, 29, 29, 29, 29, 29, 29,
  29, 29, 29, 30, 30, 30, 30, 30, 30, 30, 30, 30, 30, 30, 30, 30, 30, 31, 31, 31, 31, 31, 31, 31, 31, 31, 31, 31, 31, 31, 31, 31};
DI int t5_bucket(int dist) { return T5B[dist > 127 ? 127 : dist]; }

DI void load_row64(const bf16_t* p, float* q) {
#pragma unroll
  for (int i = 0; i < 8; ++i) {
    u32x4 v = *(const u32x4*)(p + i * 8);
#pragma unroll
    for (int j = 0; j < 4; ++j) { q[i * 8 + 2 * j] = __uint_as_float(v[j] << 16); q[i * 8 + 2 * j + 1] = __uint_as_float(v[j] & 0xffff0000u); }
  }
}
DI float dot_row64(const bf16_t* p, const float* q) {
  float acc = 0.f;
#pragma unroll
  for (int i = 0; i < 8; ++i) {
    u32x4 v = *(const u32x4*)(p + i * 8);
#pragma unroll
    for (int j = 0; j < 4; ++j) { acc += q[i * 8 + 2 * j] * __uint_as_float(v[j] << 16); acc += q[i * 8 + 2 * j + 1] * __uint_as_float(v[j] & 0xffff0000u); }
  }
  return acc;
}

#define K8_GATES 1
#define K8_INPROJ 1
#define K8_OUT 1
#define K8_UP 1
#define K8_DOWN 1
DI int colmap(int mode, int n) {
  if (mode == 4) { n = (n & ~255) + perm256(n & 255); mode = 0; }
  if (mode == 5) { n = (n & ~255) + perm256(n & 255); mode = 2; }
  if (mode == 1) { if ((n >= 2816 && K8_GATES) || (n < 2816 && K8_INPROJ)) n = (n & ~255) + perm256(n & 255); }
  if (mode == 0) return n;
  if (mode == 1) {
    if (n < 1280) return n;
    if (n < 2752) return n + 4;
    if (n < 2756) return 1280 + (n - 2752);
    if (n < 2760) return n;
    if (n < 2816) return -1;
    return n - 56;
  }
  int blk = n >> 5, w = n & 31;
  return (w < 16) ? (blk * 16 + w) : (512 + blk * 16 + (w - 16));
}
DI void transpose_tile(const float* __restrict__ src, int Nsrc, int K, bf16_t* __restrict__ dst, int n0, int k0, int mode, float (*tile)[65]) {
  const int t = tidx();
  const int n4 = (t & 15) * 4, kr = t >> 4;
  const int col = colmap(mode, n0 + n4);
  f32x4 v[8];
#pragma unroll
  for (int i = 0; i < 8; ++i) { v[i] = (f32x4){0.f, 0.f, 0.f, 0.f}; if (col >= 0) v[i] = *(const f32x4*)(src + (size_t)(k0 + kr + 32 * i) * Nsrc + col); }
#pragma unroll
  for (int i = 0; i < 8; ++i) { const int kk = kr + 32 * i; tile[kk][n4] = v[i][0]; tile[kk][n4 + 1] = v[i][1]; tile[kk][n4 + 2] = v[i][2]; tile[kk][n4 + 3] = v[i][3]; }
  __syncthreads();
  const int nn = t >> 3;
#pragma unroll
  for (int q = 0; q < 4; ++q) {
    const int k8 = (t & 7) * 8 + 64 * q;
    u32x4 o;
#pragma unroll
    for (int j = 0; j < 4; ++j) o[j] = pack2(tile[k8 + 2 * j][nn], tile[k8 + 2 * j + 1][nn]);
    *(u32x4*)(dst + (size_t)(n0 + nn) * K + k0 + k8) = o;
  }
  __syncthreads();
}
constexpr int T_IN = 108 * 4, T_BR = 4 * 16, T_OUT = 16 * 4, T_UP = 32 * 16 * 4, T_DN = 32 * 16 * 2;
constexpr int T_LAYER = T_IN + T_BR + T_OUT + T_UP + T_DN;
DI void phase_convert(const Params& p, int bid, int nblk, char* smem) {
  char* wsq = opqp(p.ws);
  float (*tile)[65] = (float (*)[65])smem;
  for (int it = bid; it < 2 * T_LAYER; it += nblk) {
    int l = it / T_LAYER, r = it % T_LAYER;
    if (r < T_IN) {
      int nt = r / 4, kt = r % 4;
      transpose_tile(p.w_in + (size_t)l * 1024 * INC, INC, 1024, (bf16_t*)(wsq + OFF_WIN) + (size_t)l * 6912 * 1024, nt * 64, kt * 256, 1, tile);
    } else if ((r -= T_IN) < T_BR) {
      int b = r / 16, nt = r % 16;
      transpose_tile(p.w_branch + (size_t)l * 1024 * 1024, 1024, 1024, (bf16_t*)(wsq + OFF_WBR) + (size_t)l * 1024 * 1024, nt * 64, b * 256, 0, tile);
    } else if ((r -= T_BR) < T_OUT) {
      int nt = r / 4, kt = r % 4;
      transpose_tile(p.w_out + (size_t)l * 1024 * 1024, 1024, 1024, (bf16_t*)(wsq + OFF_WOUT) + (size_t)l * 1024 * 1024, nt * 64, kt * 256, K8_OUT ? 4 : 0, tile);
    } else if ((r -= T_OUT) < T_UP) {
      int e = r / 64, q = r % 64, nt = q / 4, kt = q % 4;
      transpose_tile(p.w_up + ((size_t)l * 32 + e) * 1024 * 1024, 1024, 1024, (bf16_t*)(wsq + OFF_UP) + ((size_t)l * 32 + e) * 1024 * 1024, nt * 64, kt * 256, K8_UP ? 5 : 2, tile);
    } else {
      r -= T_UP;
      int e = r / 32, q = r % 32, nt = q / 2, kt = q % 2;
      transpose_tile(p.w_down + ((size_t)l * 32 + e) * 512 * 1024, 1024, 512, (bf16_t*)(wsq + OFF_DOWN) + ((size_t)l * 32 + e) * 1024 * 512, nt * 64, kt * 256, K8_DOWN ? 4 : 0, tile);
    }
  }
  if (bid == 0 && tidx() < 128) ((int*)(wsq + OFF_CNT))[tidx()] = 0;
}

DI void phase_norm(const float* __restrict__ xin, const float* __restrict__ g, bf16_t* __restrict__ hb, int bid, int nblk) {
  const int lane = tidx() & 63, wid = tidx() >> 6;
  for (int row = bid * NWV + wid; row < NT; row += nblk * NWV) {
    const float* xr = xin + (size_t)row * DM;
    f32x4 v[4]; float ss = 0.f;
#pragma unroll
    for (int i = 0; i < 4; ++i) { v[i] = *(const f32x4*)(xr + lane * 4 + 256 * i); ss += v[i][0] * v[i][0] + v[i][1] * v[i][1] + v[i][2] * v[i][2] + v[i][3] * v[i][3]; }
    ss = wave_sum(ss);
    const float r = rsqrtf(ss * (1.f / DM) + 1e-6f);
#pragma unroll
    for (int i = 0; i < 4; ++i) {
      f32x4 gg = *(const f32x4*)(g + lane * 4 + 256 * i);
      u32x2 o; o[0] = pack2(v[i][0] * r * gg[0], v[i][1] * r * gg[1]); o[1] = pack2(v[i][2] * r * gg[2], v[i][3] * r * gg[3]);
      *(u32x2*)(hb + (size_t)row * DM + lane * 4 + 256 * i) = o;
    }
  }
}

typedef __attribute__((address_space(3))) void* lds_ptr_t;
constexpr int GSTAGE = 65536;
template <int MF, class ARow>
DI void gemm_kloop(f32x4 (&acc)[MF][4], ARow arow, const bf16_t* __restrict__ Bt, int ldb, int K, char* smem) {
  const int tid = tidx(), wid = tid >> 6, lane = tid & 63, wr = wid >> 2, wc = wid & 3, fr = lane & 15, fq = lane >> 4;
  constexpr int AP = MF / 2;
  const bf16_t* ap[AP]; const bf16_t* bp[4];
  const int srow = tid >> 3, sch = tid & 7;
#pragma unroll
  for (int i = 0; i < AP; ++i) { const int r = srow + i * 64; ap[i] = arow(r) + ((sch ^ ((r >> 1) & 7)) << 3); }
#pragma unroll
  for (int i = 0; i < 4; ++i) { const int r = srow + i * 64; bp[i] = Bt + (size_t)r * ldb + ((sch ^ ((r >> 1) & 7)) << 3); }
  auto stage = [&](int buf, int kt) {
    char* SA = smem + buf * GSTAGE; char* SB = SA + 32768;
#pragma unroll
    for (int i = 0; i < AP; ++i)
      __builtin_amdgcn_global_load_lds((const void __attribute__((address_space(1)))*)(ap[i] + kt), (lds_ptr_t)(SA + tid * 16 + i * 8192), 16, 0, 0);
#pragma unroll
    for (int i = 0; i < 4; ++i)
      __builtin_amdgcn_global_load_lds((const void __attribute__((address_space(1)))*)(bp[i] + kt), (lds_ptr_t)(SB + tid * 16 + i * 8192), 16, 0, 0);
  };
  int aoff[MF], boff[4];
#pragma unroll
  for (int m = 0; m < MF; ++m) { const int r = wr * 16 * MF + m * 16 + fr; aoff[m] = r * 128 + ((fq ^ ((r >> 1) & 7)) << 4); }
#pragma unroll
  for (int n = 0; n < 4; ++n) { const int r = wc * 64 + n * 16 + fr; boff[n] = r * 128 + ((fq ^ ((r >> 1) & 7)) << 4); }
  stage(0, 0);
  asm volatile("s_waitcnt vmcnt(0)" ::: "memory");
  __syncthreads();
  int cur = 0;
#pragma unroll 1
  for (int kt = 0; kt < K; kt += 64) {
    if (kt + 64 < K) stage(cur ^ 1, kt + 64);
    const char* SA = smem + cur * GSTAGE; const char* SB = SA + 32768;
    constexpr int NST = 2 * (MF / 4);
    bf16x8 fa[2][4], fb[2][4];
    auto ldfrag = [&](int set, int st) {
      const int ks = st / (MF / 4), mh = st % (MF / 4);
#pragma unroll
      for (int n = 0; n < 4; ++n) fb[set][n] = *(const bf16x8*)(SB + (boff[n] ^ (ks << 6)));
#pragma unroll
      for (int m = 0; m < 4; ++m) fa[set][m] = *(const bf16x8*)(SA + (aoff[mh * 4 + m] ^ (ks << 6)));
    };
    ldfrag(0, 0);
    __builtin_amdgcn_sched_barrier(0);
#pragma unroll
    for (int st = 0; st < NST; ++st) {
      const int mh = st % (MF / 4);
#pragma unroll
      for (int n = 0; n < 4; ++n) acc[mh * 4][n] = __builtin_amdgcn_mfma_f32_16x16x32_bf16(fb[st & 1][n], fa[st & 1][0], acc[mh * 4][n], 0, 0, 0);
      __builtin_amdgcn_sched_barrier(0);
      if (st + 1 < NST) ldfrag((st + 1) & 1, st + 1);
      __builtin_amdgcn_sched_barrier(0);
#pragma unroll
      for (int m = 1; m < 4; ++m)
#pragma unroll
        for (int n = 0; n < 4; ++n) acc[mh * 4 + m][n] = __builtin_amdgcn_mfma_f32_16x16x32_bf16(fb[st & 1][n], fa[st & 1][m], acc[mh * 4 + m][n], 0, 0, 0);
      __builtin_amdgcn_sched_barrier(0);
    }
    asm volatile("s_waitcnt vmcnt(0)" ::: "memory");
    __syncthreads();
    cur ^= 1;
  }
}

DI int k8_lds_byte(int r, int c) { const int st = (r >> 4) * 2 + (c >> 5), rr = r & 15, cc = c & 31, ob = rr * 64 + cc * 2; return st * 1024 + (ob ^ (((ob >> 9) & 1) << 5)); }
DI void k8_stage_rc(int b, int& R, int& C) { const int st = b / 1024, sb = b % 1024, swz = sb ^ (((sb >> 9) & 1) << 5); R = (st >> 1) * 16 + swz / 64; C = (st & 1) * 32 + (swz % 64) / 2; }
template <class ARow>
DI void gemm_kloop8(f32x4 (&acc)[8][4], ARow arow, const bf16_t* __restrict__ Bt, int ldb, int K, char* smem) {
  constexpr int HTB = 16384;
  const int tid = tidx(), wid = tid >> 6, lane = tid & 63, wr = wid >> 2, wc = wid & 3, fr = lane & 15, fq = lane >> 4;
  int R0, C0; k8_stage_rc(tid * 16, R0, C0);
  unsigned aofs[2][2];
  if (!ARow::kDense) {
#pragma unroll
    for (int i = 0; i < 2; ++i)
#pragma unroll
      for (int hf = 0; hf < 2; ++hf) aofs[hf][i] = arow.off(i * 128 + hf * 64 + R0) + C0;
  } else { aofs[0][0] = arow.off(R0) + C0; }
  const unsigned astep = arow.off(64);
  const unsigned bofs0 = (unsigned)R0 * (unsigned)ldb + C0, bstep = 64u * (unsigned)ldb;
  const bf16_t* abase = arow.base;
  typedef const __attribute__((address_space(3))) char* ldsc_t;
  const int lpart = (fr * 64 + fq * 16) ^ ((fr >> 3) << 5);
  const ldsc_t la = (ldsc_t)smem + wr * 8192 + lpart;
  const ldsc_t lb = (ldsc_t)smem + wc * 4096 + lpart;
#define K8_SA(b, h) (((b) * 2 + (h)) * HTB)
#define K8_SB(b, h) ((4 + (b) * 2 + (h)) * HTB)
#define K8_STAGE_A(Pb, hf, kt) do { _Pragma("unroll") for (int _i = 0; _i < 2; ++_i) { \
    unsigned _sc = (unsigned)(kt) * 64u + (ARow::kDense ? ((hf) + 2 * _i) * astep : 0u); asm volatile("" : "+s"(_sc)); \
    __builtin_amdgcn_global_load_lds((const void __attribute__((address_space(1)))*)(abase + ((ARow::kDense ? aofs[0][0] : aofs[hf][_i]) + _sc)), (lds_ptr_t)(smem + (Pb) + tid * 16 + _i * 8192), 16, 0, 0); } } while (0)
#define K8_STAGE_B(Pb, hf, kt) do { _Pragma("unroll") for (int _i = 0; _i < 2; ++_i) { \
    unsigned _sc = (unsigned)(kt) * 64u + (2 * (hf) + _i) * bstep; asm volatile("" : "+s"(_sc)); \
    __builtin_amdgcn_global_load_lds((const void __attribute__((address_space(1)))*)(Bt + (bofs0 + _sc)), (lds_ptr_t)(smem + (Pb) + tid * 16 + _i * 8192), 16, 0, 0); } } while (0)
#define K8_LDA(dst, b, h) do { _Pragma("unroll") for (int m = 0; m < 4; ++m) { _Pragma("unroll") for (int k = 0; k < 2; ++k) \
    dst[m][k] = *(const __attribute__((address_space(3))) bf16x8*)(la + K8_SA(b, h) + (m * 2 + k) * 1024); } } while (0)
#define K8_LDB(dst, b, h) do { _Pragma("unroll") for (int n = 0; n < 2; ++n) { _Pragma("unroll") for (int k = 0; k < 2; ++k) \
    dst[n][k] = *(const __attribute__((address_space(3))) bf16x8*)(lb + K8_SB(b, h) + (n * 2 + k) * 1024); } } while (0)
#define K8_MMA(ai, bj, Af, Bf) do { __builtin_amdgcn_s_setprio(1); \
    _Pragma("unroll") for (int m = 0; m < 4; ++m) { _Pragma("unroll") for (int n = 0; n < 2; ++n) { _Pragma("unroll") for (int k = 0; k < 2; ++k) \
      acc[(ai) * 4 + m][(bj) * 2 + n] = __builtin_amdgcn_mfma_f32_16x16x32_bf16(Bf[n][k], Af[m][k], acc[(ai) * 4 + m][(bj) * 2 + n], 0, 0, 0); } } \
    __builtin_amdgcn_s_setprio(0); } while (0)
#define K8_WV(n) asm volatile("s_waitcnt vmcnt(" #n ")" ::: "memory")
#define K8_WL(n) asm volatile("s_waitcnt lgkmcnt(" #n ")" ::: "memory")
#define K8_BAR __builtin_amdgcn_s_barrier()
#define K8_SCHED __builtin_amdgcn_sched_barrier(0)
  bf16x8 At[4][2], B0[2][2], B1[2][2];
  const int nt = K / 64;
  K8_STAGE_B(K8_SB(0, 0), 0, 0); K8_STAGE_A(K8_SA(0, 0), 0, 0);
  K8_STAGE_B(K8_SB(0, 1), 1, 0); K8_STAGE_A(K8_SA(0, 1), 1, 0);
  if (wr == 1) K8_BAR;
  K8_WV(4); K8_BAR;
  K8_STAGE_B(K8_SB(1, 0), 0, 1); K8_STAGE_A(K8_SA(1, 0), 0, 1); K8_STAGE_B(K8_SB(1, 1), 1, 1);
  K8_WV(6); K8_BAR;
#pragma unroll 1
  for (int t = 0; t < nt - 2; t += 2) {
    K8_LDB(B0, 0, 0); K8_SCHED; K8_LDA(At, 0, 0); K8_STAGE_A(K8_SA(1, 1), 1, t + 1);
    K8_WL(8); K8_BAR; K8_WL(0); K8_MMA(0, 0, At, B0); K8_BAR; K8_SCHED;
    K8_LDB(B1, 0, 1); K8_STAGE_B(K8_SB(0, 0), 0, t + 2);
    K8_BAR; K8_WL(0); K8_MMA(0, 1, At, B1); K8_BAR;
    K8_LDA(At, 0, 1); K8_STAGE_A(K8_SA(0, 0), 0, t + 2);
    K8_BAR; K8_WL(0); K8_MMA(1, 0, At, B0); K8_BAR; K8_SCHED;
    K8_STAGE_B(K8_SB(0, 1), 1, t + 2);
    K8_WV(6); K8_BAR; K8_MMA(1, 1, At, B1); K8_BAR;
    K8_LDB(B0, 1, 0); K8_SCHED; K8_LDA(At, 1, 0); K8_STAGE_A(K8_SA(0, 1), 1, t + 2);
    K8_WL(8); K8_BAR; K8_WL(0); K8_MMA(0, 0, At, B0); K8_BAR; K8_SCHED;
    K8_LDB(B1, 1, 1); K8_STAGE_B(K8_SB(1, 0), 0, t + 3);
    K8_BAR; K8_WL(0); K8_MMA(0, 1, At, B1); K8_BAR;
    K8_LDA(At, 1, 1); K8_STAGE_A(K8_SA(1, 0), 0, t + 3);
    K8_BAR; K8_WL(0); K8_MMA(1, 0, At, B0); K8_BAR; K8_SCHED;
    K8_STAGE_B(K8_SB(1, 1), 1, t + 3);
    K8_WV(6); K8_BAR; K8_MMA(1, 1, At, B1); K8_BAR;
  }
  { K8_LDB(B0, 0, 0); K8_LDA(At, 0, 0); K8_STAGE_A(K8_SA(1, 1), 1, nt - 1);
    K8_BAR; K8_WL(0); K8_MMA(0, 0, At, B0); K8_BAR;
    K8_LDB(B1, 0, 1); K8_BAR; K8_WL(0); K8_MMA(0, 1, At, B1); K8_BAR;
    K8_LDA(At, 0, 1); K8_WV(4); K8_BAR; K8_WL(0); K8_MMA(1, 0, At, B0); K8_MMA(1, 1, At, B1); K8_BAR; }
  { K8_LDB(B0, 1, 0); K8_LDA(At, 1, 0); K8_WV(2); K8_BAR; K8_WL(0); K8_MMA(0, 0, At, B0); K8_BAR;
    K8_LDB(B1, 1, 1); K8_WV(0); K8_BAR; K8_WL(0); K8_MMA(0, 1, At, B1); K8_BAR;
    K8_LDA(At, 1, 1); K8_BAR; K8_WL(0); K8_MMA(1, 0, At, B0); K8_MMA(1, 1, At, B1); K8_BAR; }
  if (wr == 0) K8_BAR;
}
DI void k8_tile_end() { asm volatile("s_waitcnt vmcnt(0) lgkmcnt(0)" ::: "memory"); __syncthreads(); }

template <int MF>
DI void zero_acc(f32x4 (&acc)[MF][4]) {
#pragma unroll
  for (int m = 0; m < MF; ++m)
#pragma unroll
    for (int n = 0; n < 4; ++n) acc[m][n] = (f32x4){0.f, 0.f, 0.f, 0.f};
}
#define XCD_TILE_LOOP(n_mt, n_nt, mt, nt) \
  for (int xcd_ = bid & 7, cnt_ = ((n_nt) - xcd_ + 7) >> 3, q_ = bid >> 3, mt = 0, nt = 0; \
       q_ < (n_mt) * cnt_ && (mt = q_ / cnt_, nt = xcd_ + 8 * (q_ % cnt_), true); q_ += nblk >> 3)
#define TILE_LOOP(n_mt, n_nt, mt, nt) \
  for (int t_ = bid >> 3, mt = 0, nt = 0; t_ < (((n_mt) + 7) >> 3) * (n_nt) && (mt = (t_ / (n_nt)) * 8 + (bid & 7), nt = t_ % (n_nt), true); t_ += nblk >> 3) \
    if (mt < (n_mt))
struct RowsDense { const bf16_t* base; int ld; DI const bf16_t* operator()(int r) const { return base + (size_t)r * ld; } DI unsigned off(int r) const { return (unsigned)r * (unsigned)ld; } static constexpr bool kDense = true; };


template <int MF, class RowPtr>
DI void store_tile_bf16(const f32x4 (&v)[MF][4], char* smem, int wid, int lane, RowPtr dst) {
  char* W = smem + GSTAGE + wid * 8192;
  const int fr = lane & 15, fq = lane >> 4;
#pragma unroll
  for (int hm = 0; hm < MF / 4; ++hm) {
#pragma unroll
    for (int m = 0; m < 4; ++m)
#pragma unroll
      for (int n = 0; n < 4; ++n) {
        const int row = m * 16 + fr, c16 = 2 * n + (fq >> 1);
        u32x2 o; o[0] = pack2(v[hm * 4 + m][n][0], v[hm * 4 + m][n][1]); o[1] = pack2(v[hm * 4 + m][n][2], v[hm * 4 + m][n][3]);
        *(u32x2*)(W + row * 128 + ((c16 ^ (row & 7)) << 4) + (fq & 1) * 8) = o;
      }
    asm volatile("s_waitcnt lgkmcnt(0)" ::: "memory");
#pragma unroll
    for (int it = 0; it < 8; ++it) {
      const int row = it * 8 + (lane >> 3), c16 = lane & 7;
      const u32x4 d = *(const u32x4*)(W + row * 128 + ((c16 ^ (row & 7)) << 4));
      *(u32x4*)(dst(hm * 64 + row) + c16 * 8) = d;
    }
    asm volatile("s_waitcnt lgkmcnt(0)" ::: "memory");
  }
}

template <int MF, class RowPtr>
DI void store_tile_bf16_32(const f32x4 (&v)[MF][2], char* smem, int wid, int lane, RowPtr dst) {
  char* W = smem + GSTAGE + wid * 8192;
  const int fr = lane & 15, fq = lane >> 4;
#pragma unroll
  for (int hm = 0; hm < MF / 4; ++hm) {
#pragma unroll
    for (int m = 0; m < 4; ++m)
#pragma unroll
      for (int n = 0; n < 2; ++n) {
        const int row = m * 16 + fr, c16 = 2 * n + (fq >> 1);
        u32x2 o; o[0] = pack2(v[hm * 4 + m][n][0], v[hm * 4 + m][n][1]); o[1] = pack2(v[hm * 4 + m][n][2], v[hm * 4 + m][n][3]);
        *(u32x2*)(W + row * 64 + ((c16 ^ ((row >> 1) & 3)) << 4) + (fq & 1) * 8) = o;
      }
    asm volatile("s_waitcnt lgkmcnt(0)" ::: "memory");
#pragma unroll
    for (int it = 0; it < 4; ++it) {
      const int row = it * 16 + (lane >> 2), c16 = lane & 3;
      const u32x4 d = *(const u32x4*)(W + row * 64 + ((c16 ^ ((row >> 1) & 3)) << 4));
      *(u32x4*)(dst(hm * 64 + row) + c16 * 8) = d;
    }
    asm volatile("s_waitcnt lgkmcnt(0)" ::: "memory");
  }
}

template <int MF, class RowPtr>
DI void store_tile_u8(const f32x4 (&v)[MF][4], char* smem, int wid, int lane, RowPtr dst) {
  char* W = smem + GSTAGE + wid * 8192;
  const int fr = lane & 15, fq = lane >> 4;
#pragma unroll
  for (int hm = 0; hm < MF / 4; ++hm) {
#pragma unroll
    for (int m = 0; m < 4; ++m)
#pragma unroll
      for (int n = 0; n < 4; ++n) {
        const int row = m * 16 + fr;
        const f32x4 q = v[hm * 4 + m][n] * 255.f + 0.5f;
        const unsigned o = (unsigned)q[0] | ((unsigned)q[1] << 8) | ((unsigned)q[2] << 16) | ((unsigned)q[3] << 24);
        *(unsigned*)(W + row * 64 + ((n ^ ((row >> 1) & 3)) << 4) + fq * 4) = o;
      }
    asm volatile("s_waitcnt lgkmcnt(0)" ::: "memory");
#pragma unroll
    for (int it = 0; it < 4; ++it) {
      const int row = it * 16 + (lane >> 2), c16 = lane & 3;
      const u32x4 d = *(const u32x4*)(W + row * 64 + ((c16 ^ ((row >> 1) & 3)) << 4));
      *(u32x4*)(dst(hm * 64 + row) + c16 * 16) = d;
    }
    asm volatile("s_waitcnt lgkmcnt(0)" ::: "memory");
  }
}

template <int MF>
DI void store_tile_vt(const f32x4 (&v)[MF][4], char* smem, int wid, int lane, bf16_t* vt0) {
  char* W = smem + GSTAGE + wid * 8192;
  const int fr = lane & 15, fq = lane >> 4;
#pragma unroll
  for (int hm = 0; hm < MF / 4; ++hm) {
#pragma unroll
    for (int m = 0; m < 4; ++m) {
      const int trow = m * 16 + fr, pos = (trow & ~31) + perm32(trow & 31);
#pragma unroll
      for (int j = 0; j < 4; ++j) {
        const int dl = fq * 4 + j;
        __attribute__((address_space(3))) bf16_t* wp = (__attribute__((address_space(3))) bf16_t*)(W + dl * 128 + (((pos >> 3) ^ (dl & 7)) << 4) + (pos & 7) * 2);
#pragma unroll
        for (int n = 0; n < 4; ++n) wp[n * 1024] = (bf16_t)(pack2(v[hm * 4 + m][n][j], 0.f) & 0xffffu);
      }
    }
    asm volatile("s_waitcnt lgkmcnt(0)" ::: "memory");
#pragma unroll 1
    for (int it = 0; it < 8; ++it) {
      const int dim = it * 8 + (lane >> 3), c16 = lane & 7;
      const u32x4 d = *(const u32x4*)(W + dim * 128 + ((c16 ^ (dim & 7)) << 4));
      *(u32x4*)(vt0 + (size_t)dim * 4096 + hm * 64 + c16 * 8) = d;
    }
    asm volatile("s_waitcnt lgkmcnt(0)" ::: "memory");
  }
}

DI void phase_inproj(const Params& p, int layer, int bid, int nblk, char* smem) {
  char* wsq = opqp(p.ws);
  const bf16_t* hb = (const bf16_t*)(wsq + OFF_HB);
  const bf16_t* wt = (const bf16_t*)(wsq + OFF_WIN) + (size_t)layer * 6912 * 1024;
  constexpr int NTN = PW / 256;
  TILE_LOOP(NT / 256, NTN, mt, nt) {
    f32x4 acc[8][4]; zero_acc(acc);
    gemm_kloop8(acc, RowsDense{hb + (size_t)mt * 256 * DM, DM}, wt + (size_t)nt * 256 * DM, DM, DM, smem);
    const int t2 = tidx(), lane = t2 & 63, wid = t2 >> 6, wr = wid >> 2, wc = wid & 3, fr = lane & 15, fq = lane >> 4;
    char* ws2 = opqp(wsq);
    bf16_t* P = (bf16_t*)(ws2 + OFF_P); bf16_t* VT = (bf16_t*)(ws2 + OFF_VT);
    float* LOGF = (float*)(ws2 + OFF_LOGF); float* IW = (float*)(ws2 + OFF_IW);
    const int unit = nt * 4 + wc;
    int gsel = -1; float scale = 1.f; int vh = -1;
    if (unit < 4) { gsel = 0; scale = QS_SWA; } else if (unit < 6) gsel = 1;
    else if (unit < 8) vh = unit - 6;
    else if (unit < 12) { gsel = 2; scale = QS_FOX; } else if (unit < 16) gsel = 3;
    else if (unit < 20) vh = 2 + unit - 16;
    else if (unit < 24) scale = QS_SB;
    else if (unit >= 28 && unit < 32) vh = 6 + unit - 28;
    else if (unit >= 32 && unit < 36) { gsel = 4; scale = QS_DSA; } else if (unit == 36) gsel = 5;
    else if (unit == 37) vh = 10;
    else if (unit >= 38 && unit < 42) scale = 0.125f;
    const float* gain = p.qk_gain + (size_t)layer * 384 + (gsel < 0 ? 0 : gsel) * 64;
    if (unit == U_SM) {
#pragma unroll
      for (int m = 0; m < 8; ++m) {
        const int tok = mt * 256 + wr * 128 + m * 16 + fr;
        if (fq == 0) {
          f32x4 v = acc[m][0]; f32x4 o;
#pragma unroll
          for (int j = 0; j < 4; ++j) o[j] = log_sigmoid_f(v[j] + p.forget_bias[layer * 4 + j]);
          *(f32x4*)(LOGF + (size_t)tok * 4) = o;
        } else if (fq == 1) {
          f32x4 v = acc[m][0];
          *(f32x4*)(IW + (size_t)tok * 4) = v * 0.5f;
        }
      }
    } else {
#pragma unroll
      for (int m = 0; m < 8; ++m) {
        float r = 1.f;
        if (gsel >= 0) {
          float ss = 0.f;
#pragma unroll
          for (int n = 0; n < 4; ++n)
#pragma unroll
            for (int j = 0; j < 4; ++j) ss += acc[m][n][j] * acc[m][n][j];
          ss += __shfl_xor(ss, 16); ss += __shfl_xor(ss, 32);
          r = rsqrtf(ss * (1.f / 64.f) + 1e-6f);
        }
#pragma unroll
        for (int n = 0; n < 4; ++n) {
          f32x4 v = acc[m][n];
          if (gsel >= 0) { f32x4 gg = *(const f32x4*)(gain + n * 16 + fq * 4); v = v * r * gg; }
          acc[m][n] = v * scale;
        }
      }
      const int ln = lane, tok0 = mt * 256 + wr * 128;
      if (vh >= 0) {
        store_tile_vt<8>(acc, smem, wid, ln, VT + (((size_t)(tok0 >> 12) * 11 + vh) * 64) * 4096 + (tok0 & 4095));
      } else {
        bf16_t* pb = P + (size_t)tok0 * PW + unit * 64;
        store_tile_bf16<8>(acc, smem, wid, ln, [&](int row) { return pb + (size_t)row * PW; });
      }
    }
    k8_tile_end();
  }
}

DI void phase_cumsum(const Params& p, int bid, int nblk) {
  char* wsq = opqp(p.ws);
  const float* LOGF = (const float*)(wsq + OFF_LOGF); float* CT = (float*)(wsq + OFF_CT);
  const int lane = tidx() & 63, wid = tidx() >> 6;
  for (int seq = bid * NWV + wid; seq < 32; seq += nblk * NWV) {
    const int b = seq >> 2, h = seq & 3;
    float tot = 0.f;
    for (int i = 0; i < 64; ++i) tot += LOGF[((size_t)b * 4096 + lane * 64 + i) * 4 + h];
    float incl = tot;
    for (int o = 1; o < 64; o <<= 1) { float t = __shfl_up(incl, o); if (lane >= o) incl += t; }
    float run = incl - tot;
    for (int i = 0; i < 64; ++i) { run += LOGF[((size_t)b * 4096 + lane * 64 + i) * 4 + h]; const int sidx = lane * 64 + i; CT[((size_t)b * 4 + h) * 4096 + (sidx & ~31) + perm32(sidx & 31)] = run * LOG2E; }
  }
}

typedef float f32x16 __attribute__((ext_vector_type(16)));
#define MFMA32(a, b, c) __builtin_amdgcn_mfma_f32_32x32x16_bf16((a), (b), (c), 0, 0, 0)
#define CROW(i, h) (((i) & 3) + 8 * ((i) >> 2) + 4 * (h))
DI size_t sc_row_off(int b, int t) { const int i = t >> 5; return (size_t)b * SC_PER_B + 1024UL * ((size_t)i * (i + 1) / 2) + (size_t)(t & 31) * (size_t)((i + 1) * 32); }
DI f32x16 zero16() { f32x16 z;
#pragma unroll
  for (int i = 0; i < 16; ++i) z[i] = 0.f; return z; }
DI bf16x8 pack_step(const f32x16& x, int s) {
  u32x4 v; v[0] = pack2(x[8 * s], x[8 * s + 1]); v[1] = pack2(x[8 * s + 2], x[8 * s + 3]); v[2] = pack2(x[8 * s + 4], x[8 * s + 5]); v[3] = pack2(x[8 * s + 6], x[8 * s + 7]);
  return __builtin_bit_cast(bf16x8, v);
}
DI void load_qf(bf16x8 (&qf)[4], const bf16_t* qp) {
#pragma unroll
  for (int ks = 0; ks < 4; ++ks) qf[ks] = *(const bf16x8*)(qp + 16 * ks);
}
DI void store_ot(bf16_t* op, const f32x16 (&o)[2], float scale, int h) {
#pragma unroll
  for (int db = 0; db < 2; ++db)
#pragma unroll
    for (int g = 0; g < 4; ++g) {
      u32x2 w; w[0] = pack2(o[db][4 * g] * scale, o[db][4 * g + 1] * scale); w[1] = pack2(o[db][4 * g + 2] * scale, o[db][4 * g + 3] * scale);
      *(u32x2*)(op + 32 * db + 8 * g + 4 * h) = w;
    }
}
DI void glds16(const void* g, void* l) { __builtin_amdgcn_global_load_lds((const void __attribute__((address_space(1)))*)g, (lds_ptr_t)l, 16, 0, 0); }
DI bf16x8 lds_frag(const char* base, int row, int chunk) { return *(const bf16x8*)(base + row * 128 + ((chunk ^ ((row >> 1) & 7)) << 4)); }

DI f32x16 qk_tile(const bf16_t* kp, const bf16x8 (&qf)[4]) {
  f32x16 acc = zero16();
#pragma unroll
  for (int ks = 0; ks < 4; ++ks) { bf16x8 kf = *(const bf16x8*)(kp + 16 * ks); acc = MFMA32(kf, qf[ks], acc); }
  return acc;
}
DI void pv_tile(f32x16 (&o)[2], const bf16_t* vp, const f32x16& pacc) {
#pragma unroll
  for (int s = 0; s < 2; ++s) {
    const bf16x8 pb = pack_step(pacc, s);
#pragma unroll
    for (int db = 0; db < 2; ++db) { const bf16x8 vf = *(const bf16x8*)(vp + (size_t)db * 32 * 4096 + 8 * s); o[db] = MFMA32(vf, pb, o[db]); }
  }
}
DI void fast_swa(const Params& p, int layer, int b, int hq, int qt, int lane, const float* tb  ) {
  const bf16_t* P = (const bf16_t*)(p.ws + OFF_P); bf16_t* O = (bf16_t*)(p.ws + OFF_O);
  const int kv = hq >> 1;
  const bf16_t* vt = (const bf16_t*)(p.ws + OFF_VT) + ((size_t)b * 11 + kv) * 64 * 4096;
  const int r = lane & 31, h = lane >> 5, q0 = qt * 32;
  bf16x8 qf[4]; load_qf(qf, P + (size_t)(b * 4096 + q0 + r) * PW + (U_AQ + hq) * 64 + 8 * h);
  f32x16 o[2]; o[0] = zero16(); o[1] = zero16();
  float m = p.attn_sinks[layer * 4 + hq] * LOG2E, l = (h == 0) ? 1.f : 0.f;
  const bf16_t* kbase = P + (size_t)(b * 4096 + r) * PW + (U_AK + kv) * 64 + 8 * h;
  const bf16_t* vbase = vt + (size_t)r * 4096 + 16 * h;
  for (int kb = (qt >= 4 ? qt - 4 : 0); kb <= qt; ++kb) {
    const int key0 = kb * 32;
    f32x16 s = qk_tile(kbase + (size_t)key0 * PW, qf);
#pragma unroll
    for (int i = 0; i < 16; ++i) {
      const int dist = q0 + r - key0 - CROW(i, h);
      const bool ok = dist >= 0 && dist < 128;
      s[i] = ok ? s[i] + tb[hq * 128 + (dist & 127)] : -INFINITY;
    }
    float ml = s[0];
#pragma unroll
    for (int i = 1; i < 16; ++i) ml = fmaxf(ml, s[i]);
    ml = fmaxf(ml, __shfl_xor(ml, 32));
    const float mn = fmaxf(m, ml);
    const float alpha = __builtin_amdgcn_exp2f(m - mn);
    float ps = 0.f;
#pragma unroll
    for (int i = 0; i < 16; ++i) { s[i] = __builtin_amdgcn_exp2f(s[i] - mn); ps += s[i]; }
    l = l * alpha + ps; m = mn;
#pragma unroll
    for (int i = 0; i < 16; ++i) { o[0][i] *= alpha; o[1][i] *= alpha; }
    pv_tile(o, vbase + key0, s);
  }
  l += __shfl_xor(l, 32);
  store_ot(O + (size_t)(b * 4096 + q0 + r) * 1024 + hq * 64, o, 1.f / l, h);
}

constexpr int ABUF = 16384 + 2048, RING = 4;
struct KVStream {
  const bf16_t* kg; const bf16_t* vg; const float* cg; int tid;
  DI void stage(char* smem, int buf, int j) const {
    char* B = smem + buf * ABUF;
    glds16(kg + (size_t)64 * j * PW, B + tid * 16);
    glds16(vg + 64 * j, B + 8192 + tid * 16);
    if (cg) { if ((tid & 63) < 2) glds16(cg + 64 * j, B + 16384 + ((tid >> 6) * 2 + (tid & 63)) * 16); }
  }
};
DI KVStream make_stream(const bf16_t* krow0  , const bf16_t* vt  , const float* c  , int tid) {
  const int srow = tid >> 3, sch = tid & 7, fs = (srow >> 1) & 7;
  KVStream st; st.tid = tid;
  st.kg = krow0 + (size_t)srow * PW + ((sch ^ fs) << 3);
  st.vg = vt + (size_t)srow * 4096 + ((sch ^ fs) << 3);
  st.cg = c ? c + 4 * ((tid >> 6) * 2 + (tid & 63)) : nullptr;
  return st;
}
template <int NL> DI void ring_wait_barrier(int ahead) {
  if (NL == 3) { if (ahead >= 2) asm volatile("s_waitcnt vmcnt(6)" ::: "memory"); else if (ahead == 1) asm volatile("s_waitcnt vmcnt(3)" ::: "memory"); else asm volatile("s_waitcnt vmcnt(0)" ::: "memory"); }
  else { if (ahead >= 2) asm volatile("s_waitcnt vmcnt(4)" ::: "memory"); else if (ahead == 1) asm volatile("s_waitcnt vmcnt(2)" ::: "memory"); else asm volatile("s_waitcnt vmcnt(0)" ::: "memory"); }
  asm volatile("s_waitcnt lgkmcnt(0)" ::: "memory");
  __builtin_amdgcn_s_barrier();
  asm volatile("" ::: "memory");
}
DI f32x16 qk_lds(const char* KB, int u, int r, int h, const bf16x8 (&qf)[4]) {
  f32x16 acc = zero16();
#pragma unroll
  for (int ks = 0; ks < 4; ++ks) acc = MFMA32(lds_frag(KB, 32 * u + r, 2 * ks + h), qf[ks], acc);
  return acc;
}
DI void pv_lds(f32x16 (&o)[2], const char* VB, int u, int r, int h, const f32x16& pacc) {
#pragma unroll
  for (int s = 0; s < 2; ++s) {
    const bf16x8 pb = pack_step(pacc, s);
#pragma unroll
    for (int db = 0; db < 2; ++db) o[db] = MFMA32(lds_frag(VB, 32 * db + r, 4 * u + 2 * h + s), pb, o[db]);
  }
}
DI float max3f(float a, float b, float c) { float r; asm("v_max3_f32 %0, %1, %2, %3" : "=v"(r) : "v"(a), "v"(b), "v"(c)); return r; }
DI void pk_sub_scalar(f32x16& s, float m) {
  const f32x2 mm = {m, m};
#pragma unroll
  for (int i = 0; i < 8; ++i) {
    f32x2 t = {s[2 * i], s[2 * i + 1]}, r;
    asm("v_pk_add_f32 %0, %1, %2 neg_lo:[0,1] neg_hi:[0,1]" : "=v"(r) : "v"(t), "v"(mm));
    s[2 * i] = r[0]; s[2 * i + 1] = r[1];
  }
}
DI float pk_sum(const f32x16& s) {
  f32x2 a = {s[0], s[1]}, b = {s[2], s[3]};
#pragma unroll
  for (int i = 2; i < 8; i += 2) { a = a + (f32x2){s[2 * i], s[2 * i + 1]}; b = b + (f32x2){s[2 * i + 2], s[2 * i + 3]}; }
  a = a + b; return a[0] + a[1];
}
DI void online_softmax(f32x16& s, float& m, float& l, f32x16 (&o)[2]) {
  float ml = max3f(s[0], s[1], s[2]);
#pragma unroll
  for (int i = 3; i < 15; i += 2) ml = max3f(ml, s[i], s[i + 1]);
  ml = max3f(ml, s[15], __shfl_xor(max3f(ml, s[15], s[15]), 32));
  if (__builtin_expect(__ballot(ml > m + 8.f) != 0ULL, 0)) {
    const float mn = fmaxf(m, ml);
    const float ms = (mn == -INFINITY) ? 0.f : mn;
    const float alpha = __builtin_amdgcn_exp2f(m - ms);
    l *= alpha; m = mn;
    const f32x2 aa = {alpha, alpha};
#pragma unroll
    for (int i = 0; i < 8; ++i) {
      f32x2 t0 = {o[0][2 * i], o[0][2 * i + 1]}, t1 = {o[1][2 * i], o[1][2 * i + 1]};
      t0 = t0 * aa; t1 = t1 * aa; o[0][2 * i] = t0[0]; o[0][2 * i + 1] = t0[1]; o[1][2 * i] = t1[0]; o[1][2 * i + 1] = t1[1];
    }
  }
  pk_sub_scalar(s, (m == -INFINITY) ? 0.f : m);
#pragma unroll
  for (int i = 0; i < 16; ++i) s[i] = __builtin_amdgcn_exp2f(s[i]);
  l += pk_sum(s);
}


DI void qk_lds2(f32x16& s0, f32x16& s1, const char* KB, int r, int h, const bf16x8 (&qf)[4]) {
  bf16x8 k0[4], k1[4];
#pragma unroll
  for (int ks = 0; ks < 4; ++ks) { k0[ks] = lds_frag(KB, r, 2 * ks + h); k1[ks] = lds_frag(KB, 32 + r, 2 * ks + h); }
  s0 = zero16(); s1 = zero16();
#pragma unroll
  for (int ks = 0; ks < 4; ++ks) { s0 = MFMA32(k0[ks], qf[ks], s0); s1 = MFMA32(k1[ks], qf[ks], s1); }
}
DI void ld_vfrags(bf16x8 (&vf)[2][2][2], const char* VB, int r, int h) {
#pragma unroll
  for (int u = 0; u < 2; ++u)
#pragma unroll
    for (int db = 0; db < 2; ++db)
#pragma unroll
      for (int sx = 0; sx < 2; ++sx) vf[u][db][sx] = lds_frag(VB, 32 * db + r, 4 * u + 2 * h + sx);
}
DI void pv2(f32x16 (&o)[2], const bf16x8 (&vf)[2][2][2], const f32x16& p0, const f32x16& p1) {
#pragma unroll
  for (int sx = 0; sx < 2; ++sx) {
    const bf16x8 pb0 = pack_step(p0, sx), pb1 = pack_step(p1, sx);
#pragma unroll
    for (int db = 0; db < 2; ++db) { o[db] = MFMA32(vf[0][db][sx], pb0, o[db]); o[db] = MFMA32(vf[1][db][sx], pb1, o[db]); }
  }
}
DI void online_softmax2(f32x16& s0, f32x16& s1, float& m, float& l, f32x16 (&o)[2]) {
  float ml = max3f(s0[0], s0[1], s1[0]);
#pragma unroll
  for (int i = 1; i < 15; i += 2) { ml = max3f(ml, s0[i + 1], s0[i + 2 > 15 ? 15 : i + 2]); ml = max3f(ml, s1[i], s1[i + 1]); }
  ml = max3f(ml, s1[15], s0[15]);
  ml = fmaxf(ml, __shfl_xor(ml, 32));
  if (__builtin_expect(__ballot(ml > m + 8.f) != 0ULL, 0)) {
    const float mn = fmaxf(m, ml);
    const float ms = (mn == -INFINITY) ? 0.f : mn;
    const float alpha = __builtin_amdgcn_exp2f(m - ms);
    l *= alpha; m = mn;
    const f32x2 aa = {alpha, alpha};
#pragma unroll
    for (int i = 0; i < 8; ++i) {
      f32x2 t0 = {o[0][2 * i], o[0][2 * i + 1]}, t1 = {o[1][2 * i], o[1][2 * i + 1]};
      t0 = t0 * aa; t1 = t1 * aa; o[0][2 * i] = t0[0]; o[0][2 * i + 1] = t0[1]; o[1][2 * i] = t1[0]; o[1][2 * i + 1] = t1[1];
    }
  }
  const float mr = (m == -INFINITY) ? 0.f : m;
  pk_sub_scalar(s0, mr); pk_sub_scalar(s1, mr);
#pragma unroll
  for (int i = 0; i < 16; ++i) { s0[i] = __builtin_amdgcn_exp2f(s0[i]); s1[i] = __builtin_amdgcn_exp2f(s1[i]); }
  l += pk_sum(s0) + pk_sum(s1);
}

DI void fox_block(const Params& p, int b, int hd, int qb, char* smem) {
  char* wsq = opqp(p.ws);
  const bf16_t* P = (const bf16_t*)(wsq + OFF_P); bf16_t* O = (bf16_t*)(wsq + OFF_O);
  const int tid = tidx(), lane = tid & 63, wid = __builtin_amdgcn_readfirstlane(tid >> 6), r = lane & 31, h = lane >> 5;
  const int q0 = qb * 256 + 32 * wid, ntile = qb * 4 + 4, jmax = (q0 + 31) >> 6;
  const KVStream st = make_stream(P + (size_t)b * 4096 * PW + (U_FK + hd) * 64, (const bf16_t*)(wsq + OFF_VT) + ((size_t)b * 11 + 2 + hd) * 64 * 4096,
                                  (const float*)(wsq + OFF_CT) + ((size_t)b * 4 + hd) * 4096, tid);
  bf16x8 qf[4]; load_qf(qf, P + (size_t)(b * 4096 + q0 + r) * PW + (U_FQ + hd) * 64 + 8 * h);
  asm volatile("" :: "v"(qf[0]), "v"(qf[1]), "v"(qf[2]), "v"(qf[3]));
  f32x16 o[2]; o[0] = zero16(); o[1] = zero16();
  float m = -INFINITY, l = 0.f;
  __syncthreads();
#pragma unroll 1
  for (int j = 0; j < RING - 1 && j < ntile; ++j) st.stage(smem, j, j);
  ring_wait_barrier<3>((ntile - 1 < RING - 2 ? ntile - 1 : RING - 2));
#pragma unroll 1
  for (int j = 0; j < ntile; ++j) {
    if (j + RING - 1 < ntile) st.stage(smem, (j + RING - 1) & (RING - 1), j + RING - 1);
    if (j <= jmax) {
      const char* B = smem + (j & (RING - 1)) * ABUF;
      f32x16 s0, s1;
      qk_lds2(s0, s1, B, r, h, qf);
      bf16x8 vf[2][2][2]; ld_vfrags(vf, B + 8192, r, h);
#pragma unroll
      for (int g = 0; g < 4; ++g) {
        const f32x4 ca = *(const f32x4*)(B + 16384 + (16 * h + 4 * g) * 4), cb = *(const f32x4*)(B + 16384 + (32 + 16 * h + 4 * g) * 4);
        f32x2 t0 = {s0[4 * g], s0[4 * g + 1]}, t1 = {s0[4 * g + 2], s0[4 * g + 3]}, t2 = {s1[4 * g], s1[4 * g + 1]}, t3 = {s1[4 * g + 2], s1[4 * g + 3]};
        t0 = t0 - (f32x2){ca[0], ca[1]}; t1 = t1 - (f32x2){ca[2], ca[3]}; t2 = t2 - (f32x2){cb[0], cb[1]}; t3 = t3 - (f32x2){cb[2], cb[3]};
        s0[4 * g] = t0[0]; s0[4 * g + 1] = t0[1]; s0[4 * g + 2] = t1[0]; s0[4 * g + 3] = t1[1];
        s1[4 * g] = t2[0]; s1[4 * g + 1] = t2[1]; s1[4 * g + 2] = t3[0]; s1[4 * g + 3] = t3[1];
      }
      if (__builtin_expect(64 * j + 63 > q0, 0)) {
#pragma unroll
        for (int i = 0; i < 16; ++i) {
          if (64 * j + CROW(i, h) > q0 + r) s0[i] = -INFINITY;
          if (64 * j + 32 + CROW(i, h) > q0 + r) s1[i] = -INFINITY;
        }
        asm volatile("" ::: "memory");
      }
      online_softmax2(s0, s1, m, l, o);
      pv2(o, vf, s0, s1);
    }
    if (j + 1 < ntile) ring_wait_barrier<3>((ntile - 1 < j + RING - 1 ? ntile - 1 : j + RING - 1) - (j + 1));
  }
  l += __shfl_xor(l, 32);
  store_ot(O + (size_t)(b * 4096 + q0 + r) * 1024 + 256 + hd * 64, o, 1.f / l, h);
}

DI void sb_block(const Params& p, int b, int hd, int qb, char* smem) {
  char* wsq = opqp(p.ws);
  const bf16_t* P = (const bf16_t*)(wsq + OFF_P); bf16_t* O = (bf16_t*)(wsq + OFF_O);
  const int tid = tidx(), lane = tid & 63, wid = __builtin_amdgcn_readfirstlane(tid >> 6), r = lane & 31, h = lane >> 5;
  const int q0 = qb * 256 + 32 * wid, ntile = qb * 4 + 4, jmax = (q0 + 31) >> 6;
  const KVStream st = make_stream(P + (size_t)b * 4096 * PW + (U_SK + hd) * 64, (const bf16_t*)(wsq + OFF_VT) + ((size_t)b * 11 + 6 + hd) * 64 * 4096, nullptr, tid);
  bf16x8 qf[4]; load_qf(qf, P + (size_t)(b * 4096 + q0 + r) * PW + (U_SQ + hd) * 64 + 8 * h);
  asm volatile("" :: "v"(qf[0]), "v"(qf[1]), "v"(qf[2]), "v"(qf[3]));
  f32x16 o[2]; o[0] = zero16(); o[1] = zero16();
  float R = 0.f;
  volatile int* flg = (volatile int*)(smem + RING * ABUF);
  __syncthreads();
#pragma unroll 1
  for (int it = 0; it < RING - 1 && it < ntile; ++it) st.stage(smem, it, ntile - 1 - it);
  ring_wait_barrier<2>((ntile - 1 < RING - 2 ? ntile - 1 : RING - 2));
#pragma unroll 1
  for (int it = 0; it < ntile; ++it) {
    const int j = ntile - 1 - it;
    if (it + RING - 1 < ntile) st.stage(smem, (it + RING - 1) & (RING - 1), j - (RING - 1));
    const bool wdone = __ballot(R >= -160.f) == 0ULL;
    if (j <= jmax && !wdone) {
      const char* B = smem + (it & (RING - 1)) * ABUF;
#pragma unroll
      for (int uu = 0; uu < 2; ++uu) {
        const int u = 1 - uu, key0 = 64 * j + 32 * u;
        if (key0 <= q0) {
          const bool diag = key0 == q0;
          f32x16 z = qk_lds(B, u, r, h, qf);
          f32x16 lk;
#pragma unroll
          for (int i = 0; i < 16; ++i) {
            const float t = __builtin_amdgcn_exp2f(-fabsf(z[i]));
            lk[i] = -(fmaxf(z[i], 0.f) + __builtin_amdgcn_logf(1.f + t));
          }
          if (diag) {
#pragma unroll
            for (int i = 0; i < 16; ++i) if (CROW(i, h) >= r) lk[i] = 0.f;
          }
          float gs[4], ps[4];
#pragma unroll
          for (int g = 0; g < 4; ++g) { gs[g] = (lk[4 * g] + lk[4 * g + 1]) + (lk[4 * g + 2] + lk[4 * g + 3]); ps[g] = __shfl_xor(gs[g], 32); }
          float run = R;
          f32x16 a;
#pragma unroll
          for (int g = 3; g >= 0; --g) {
            float later = run + (h == 0 ? ps[g] : 0.f);
#pragma unroll
            for (int jj = 3; jj >= 0; --jj) { const int i = 4 * g + jj; a[i] = __builtin_amdgcn_exp2f(z[i] + lk[i] + later); later += lk[i]; }
            run += gs[g] + ps[g];
          }
          R = run;
          if (diag) {
#pragma unroll
            for (int i = 0; i < 16; ++i) if (CROW(i, h) >= r) a[i] = 0.f;
          }
          pv_lds(o, B + 8192, u, r, h, a);
        }
      }
    }
    if (it + 1 < ntile) {
      if (lane == 0) flg[(it & 1) * 8 + wid] = (__ballot(R >= -160.f) == 0ULL) ? 1 : 0;
      ring_wait_barrier<2>((ntile - 1 < it + RING - 1 ? ntile - 1 : it + RING - 1) - (it + 1));
      int alld = 1;
#pragma unroll
      for (int w = 0; w < 8; ++w) alld &= flg[(it & 1) * 8 + w];
      if (alld) { asm volatile("s_waitcnt vmcnt(0)" ::: "memory"); break; }
    }
  }
  store_ot(O + (size_t)(b * 4096 + q0 + r) * 1024 + 512 + hd * 64, o, 1.f, h);
}


DI void swa_block(const Params& p, int layer, int b, int kv, int qb, char* smem, const float* tb  ) {
  char* wsq = opqp(p.ws);
  const bf16_t* P = (const bf16_t*)(wsq + OFF_P); bf16_t* O = (bf16_t*)(wsq + OFF_O);
  const int tid = tidx(), lane = tid & 63, wid = __builtin_amdgcn_readfirstlane(tid >> 6), r = lane & 31, h = lane >> 5;
  const int q0 = qb * 256 + 32 * wid, jlo = qb > 0 ? qb * 4 - 2 : 0, ntile = qb * 4 + 4 - jlo;
  const KVStream st = make_stream(P + (size_t)b * 4096 * PW + (U_AK + kv) * 64, (const bf16_t*)(wsq + OFF_VT) + ((size_t)b * 11 + kv) * 64 * 4096, nullptr, tid);
  bf16x8 qf[2][4];
#pragma unroll
  for (int g = 0; g < 2; ++g) load_qf(qf[g], P + (size_t)(b * 4096 + q0 + r) * PW + (U_AQ + 2 * kv + g) * 64 + 8 * h);
  asm volatile("" :: "v"(qf[0][0]), "v"(qf[0][1]), "v"(qf[0][2]), "v"(qf[0][3]), "v"(qf[1][0]), "v"(qf[1][1]), "v"(qf[1][2]), "v"(qf[1][3]));
  f32x16 o[2][2];
  float m[2], l[2];
#pragma unroll
  for (int g = 0; g < 2; ++g) { o[g][0] = zero16(); o[g][1] = zero16(); m[g] = p.attn_sinks[layer * 4 + 2 * kv + g] * LOG2E; l[g] = (h == 0) ? 1.f : 0.f; }
  __syncthreads();
#pragma unroll 1
  for (int it = 0; it < RING - 1 && it < ntile; ++it) st.stage(smem, it, jlo + it);
  ring_wait_barrier<2>((ntile - 1 < RING - 2 ? ntile - 1 : RING - 2));
#pragma unroll 1
  for (int it = 0; it < ntile; ++it) {
    const int j = jlo + it;
    if (it + RING - 1 < ntile) st.stage(smem, (it + RING - 1) & (RING - 1), j + RING - 1);
    const char* B = smem + (it & (RING - 1)) * ABUF;
#pragma unroll
    for (int u = 0; u < 2; ++u) {
      const int key0 = 64 * j + 32 * u;
      if (key0 <= q0 && key0 + 128 >= q0) {
        const bool edge = (key0 == q0) || (key0 + 128 == q0);
#pragma unroll
        for (int g = 0; g < 2; ++g) {
          f32x16 s = qk_lds(B, u, r, h, qf[g]);
          const float* tbh = tb + (2 * kv + g) * 128;
#pragma unroll
          for (int i = 0; i < 16; ++i) {
            const int dist = q0 + r - key0 - CROW(i, h);
            s[i] += tbh[dist & 127];
            if (edge && (dist < 0 || dist >= 128)) s[i] = -INFINITY;
          }
          online_softmax(s, m[g], l[g], o[g]);
          pv_lds(o[g], B + 8192, u, r, h, s);
        }
      }
    }
    if (it + 1 < ntile) ring_wait_barrier<2>((ntile - 1 < it + RING - 1 ? ntile - 1 : it + RING - 1) - (it + 1));
  }
#pragma unroll
  for (int g = 0; g < 2; ++g) {
    const float lt = l[g] + __shfl_xor(l[g], 32);
    store_ot(O + (size_t)(b * 4096 + q0 + r) * 1024 + (2 * kv + g) * 64, o[g], 1.f / lt, h);
  }
}

DI void dsa_block(const Params& p, int b, int qb, char* smem, const float* tb  ) {
  char* wsq = opqp(p.ws);
  const bf16_t* P = (const bf16_t*)(wsq + OFF_P); bf16_t* O = (bf16_t*)(wsq + OFF_O);
  const unsigned* MW = (const unsigned*)(wsq + OFF_MASK);
  const int tid = tidx(), lane = tid & 63, wid = __builtin_amdgcn_readfirstlane(tid >> 6), r = lane & 31, h = lane >> 5;
  const int hd = wid & 3, q0 = qb * 64 + 32 * (wid >> 2), ntile = qb + 1;
  const KVStream st = make_stream(P + (size_t)b * 4096 * PW + U_DK * 64, (const bf16_t*)(wsq + OFF_VT) + ((size_t)b * 11 + 10) * 64 * 4096, nullptr, tid);
  bf16x8 qf[4]; load_qf(qf, P + (size_t)(b * 4096 + q0 + r) * PW + (U_DQ + hd) * 64 + 8 * h);
  asm volatile("" :: "v"(qf[0]), "v"(qf[1]), "v"(qf[2]), "v"(qf[3]));
  f32x16 o[2]; o[0] = zero16(); o[1] = zero16();
  float m = -INFINITY, l = 0.f;
  const unsigned* mrow = MW + (size_t)(b * 4096 + q0 + r) * 128 + h;
  const float bfar = tb[hd * 128 + 127];
  auto stage_all = [&](int buf, int j) {
    st.stage(smem, buf, j);
    __builtin_amdgcn_global_load_lds((const void __attribute__((address_space(1)))*)(mrow + 2 * j), (lds_ptr_t)(smem + buf * ABUF + 16384 + wid * 256 + lane * 4), 4, 0, 0);
  };
  __syncthreads();
#pragma unroll 1
  for (int j = 0; j < RING - 1 && j < ntile; ++j) stage_all(j, j);
  ring_wait_barrier<3>((ntile - 1 < RING - 2 ? ntile - 1 : RING - 2));
#pragma unroll 1
  for (int j = 0; j < ntile; ++j) {
    if (j + RING - 1 < ntile) stage_all((j + RING - 1) & (RING - 1), j + RING - 1);
    const char* B = smem + (j & (RING - 1)) * ABUF;
#pragma unroll
    for (int u = 0; u < 2; ++u) {
      const unsigned word = *(const unsigned*)(B + 16384 + wid * 256 + (u * 32 + r) * 4);
      if (__ballot(word != 0u) != 0ULL) {
        const int key0 = 64 * j + 32 * u;
        const unsigned wh = word >> (4 * h);
        f32x16 s = qk_lds(B, u, r, h, qf);
        if (q0 - key0 - 31 >= 113) {
#pragma unroll
          for (int i = 0; i < 16; ++i) s[i] += bfar;
        } else {
#pragma unroll
          for (int i = 0; i < 16; ++i) { int dist = q0 + r - key0 - CROW(i, h); dist = dist < 0 ? 0 : (dist > 127 ? 127 : dist); s[i] += tb[hd * 128 + dist]; }
        }
#pragma unroll
        for (int i = 0; i < 16; ++i) { const int bit = (i & 3) + 8 * (i >> 2); if (!((wh >> bit) & 1u)) s[i] = -INFINITY; }
        online_softmax(s, m, l, o);
        pv_lds(o, B + 8192, u, r, h, s);
      }
    }
    if (j + 1 < ntile) ring_wait_barrier<3>((ntile - 1 < j + RING - 1 ? ntile - 1 : j + RING - 1) - (j + 1));
  }
  l += __shfl_xor(l, 32);
  store_ot(O + (size_t)(b * 4096 + q0 + r) * 1024 + 768 + hd * 64, o, 1.f / l, h);
}

constexpr int IBUF = 32768;
DI void idx_block(const Params& p, int b, int qb, char* smem) {
  char* wsq = opqp(p.ws);
  const bf16_t* P = (const bf16_t*)(wsq + OFF_P); const float* IW = (const float*)(wsq + OFF_IW); float* SC = (float*)(wsq + OFF_R);
  const int tid = tidx(), lane = tid & 63, wid = __builtin_amdgcn_readfirstlane(tid >> 6), r = lane & 31, h = lane >> 5;
  const int kp = wid >> 1, q0 = qb * 64 + 32 * (wid & 1), tok = b * 4096 + q0 + r, nround = (qb >> 2) + 1;
  const int srow = tid >> 3, sch = tid & 7, fs = (srow >> 1) & 7;
  const bf16_t* kg = P + (size_t)(b * 4096 + srow) * PW + U_IK * 64 + ((sch ^ fs) << 3);
  auto stage = [&](int buf, int R) {
    char* B = smem + buf * IBUF;
#pragma unroll
    for (int i = 0; i < 4; ++i) glds16(kg + (size_t)(256 * R + 64 * i) * PW, B + i * 8192 + tid * 16);
  };
  bf16x8 qf[4][4];
#pragma unroll
  for (int hh = 0; hh < 4; ++hh) load_qf(qf[hh], P + (size_t)tok * PW + (U_IQ + hh) * 64 + 8 * h);
  const f32x4 w = *(const f32x4*)(IW + (size_t)tok * 4);
  float* row = SC + sc_row_off(b, q0 + r) + 4 * h;
  stage(0, 0);
  asm volatile("s_waitcnt vmcnt(0)" ::: "memory");
  __syncthreads();
  f32x16 pend[2]; int pkey[2] = {-1, -1};
  auto flush = [&]() {
#pragma unroll
    for (int u = 0; u < 2; ++u) if (pkey[u] >= 0) {
#pragma unroll
      for (int g = 0; g < 4; ++g) { f32x4 v = {pend[u][4 * g], pend[u][4 * g + 1], pend[u][4 * g + 2], pend[u][4 * g + 3]}; *(f32x4*)(row + pkey[u] + 8 * g) = v; }
    }
  };
#pragma unroll 1
  for (int R = 0; R < nround; ++R) {
    if (R + 1 < nround) stage((R + 1) & 1, R + 1);
    flush();
    const char* KB = smem + (R & 1) * IBUF + kp * 8192;
#pragma unroll
    for (int u = 0; u < 2; ++u) {
      const int key0 = 256 * R + 64 * kp + 32 * u;
      pkey[u] = -1;
      if (key0 <= q0) {
        bf16x8 kf[4];
#pragma unroll
        for (int ks = 0; ks < 4; ++ks) kf[ks] = lds_frag(KB, 32 * u + r, 2 * ks + h);
        f32x16 sc = zero16();
#pragma unroll
        for (int hh = 0; hh < 4; ++hh) {
          f32x16 acc = zero16();
#pragma unroll
          for (int ks = 0; ks < 4; ++ks) acc = MFMA32(kf[ks], qf[hh][ks], acc);
#pragma unroll
          for (int i = 0; i < 16; ++i) sc[i] += w[hh] * fmaxf(acc[i], 0.f);
          __builtin_amdgcn_sched_barrier(0);
        }
#pragma unroll
        for (int i = 0; i < 16; ++i) sc[i] += 0.f;
        if (key0 == q0) {
#pragma unroll
          for (int i = 0; i < 16; ++i) if (CROW(i, h) > r) sc[i] = -INFINITY;
        }
        pend[u] = sc; pkey[u] = key0;
      }
    }
    asm volatile("s_waitcnt vmcnt(0)" ::: "memory");
    __syncthreads();
  }
  flush();
}

DI void build_bias_table(const Params& p, float* tb, int hoff) {
  for (int i = tidx(); i < 512; i += NTHR) { const int hd = i >> 7, dist = i & 127; tb[i] = p.t5[T5B[dist] * 8 + hoff + hd] * LOG2E; }
  __syncthreads();
}

DI int wave_sum_i(int v) {
  int tot = 0;
#pragma unroll
  for (int b = 0; b < 7; ++b) tot += __builtin_popcountll(__ballot((v >> b) & 1)) << b;
  return tot;
}
DI float wave_min(float v) { for (int o = 32; o > 0; o >>= 1) v = fminf(v, __shfl_xor(v, o)); return v; }
DI unsigned f2key(float f) { unsigned b = __float_as_uint(f); return (b & 0x80000000u) ? ~b : (b | 0x80000000u); }
DI float key2f(unsigned k) { return __uint_as_float((k & 0x80000000u) ? (k & 0x7fffffffu) : ~k); }
DI void dsa_select2(const Params& p, int item, int lane) {
  char* wsq = opqp(p.ws);
  const float* SC = (const float*)(wsq + OFF_R); u64* MASK = (u64*)(wsq + OFF_MASK);
  const int t = item & 4095, b = item >> 12, tok = b * 4096 + t;
  const float* row = SC + sc_row_off(b, t);
  u64 myword = 0;
  if (t < 256) {
#pragma unroll
    for (int r = 0; r < 4; ++r) { u64 w = __ballot((r * 64 + lane) <= t); if (lane == r) myword = w; }
  } else {
    const int nch = (t >> 10) + 1;
    f32x2 xp[32];
#define XS(r) xp[(r) >> 1][(r) & 1]
#pragma unroll
    for (int c = 0; c < 4; ++c) {
      if (c < nch) {
#pragma unroll
        for (int rr = 0; rr < 16; ++rr) { const int r = c * 16 + rr, s = r * 64 + lane; XS(r) = (s <= t) ? row[s] : -INFINITY; }
      } else {
#pragma unroll
        for (int rr = 0; rr < 16; ++rr) XS(c * 16 + rr) = -INFINITY;
      }
    }
    auto count_ge = [&](float v) -> int {
      const f32x2 vv = {v, v};
      int lt = 0;
#pragma unroll
      for (int c = 0; c < 4; ++c) if (c < nch) {
#pragma unroll
        for (int q = 0; q < 8; ++q) {
          f32x2 d;
          asm("v_pk_add_f32 %0, %1, %2 neg_lo:[0,1] neg_hi:[0,1]" : "=v"(d) : "v"(xp[c * 8 + q]), "v"(vv));
          lt += (int)(__float_as_uint(d[0]) >> 31) + (int)(__float_as_uint(d[1]) >> 31);
        }
      }
      return nch * 1024 - (wave_sum_i(lt & 127) + ((__builtin_popcountll(__ballot(lt >> 7))) << 7));
    };
    float mx = -INFINITY, mn = INFINITY;
#pragma unroll
    for (int c = 0; c < 4; ++c) if (c < nch) {
#pragma unroll
      for (int rr = 0; rr < 16; ++rr) { const float v = XS(c * 16 + rr); mx = fmaxf(mx, v); mn = fminf(mn, v == -INFINITY ? INFINITY : v); }
    }
    mx = wave_max(mx); mn = wave_min(mn);
    float T = mx; bool exact = false;
    int chi = count_ge(mx);
    if (chi < 256) {
      float lo = mn, hi = mx; int clo = t + 1;
      if (lo < 0.f && hi > 0.f) { const int c0 = count_ge(0.f); if (c0 >= 256) { lo = 0.f; clo = c0; } else { hi = 0.f; chi = c0; } }
      float glo = __builtin_amdgcn_logf((float)clo + 0.5f) - 8.0028150f, ghi = __builtin_amdgcn_logf((float)chi + 0.5f) - 8.0028150f;
      int side = 0; bool conv = false;
      for (int it = 0; it < 40; ++it) {
        if (clo == 256) { T = lo; exact = true; break; }
        const float frac = fminf(fmaxf(glo / (glo - ghi), 0.01f), 0.99f);
        float mid = lo + (hi - lo) * frac;
        if (!(mid > lo && mid < hi)) { mid = lo + (hi - lo) * 0.5f; if (!(mid > lo && mid < hi)) { conv = true; break; } }
        const int c = count_ge(mid);
        if (c == 256) { T = mid; exact = true; break; }
        const float gm = __builtin_amdgcn_logf((float)c + 0.5f) - 8.0028150f;
        if (c > 256) { lo = mid; clo = c; glo = gm; if (side == 1) ghi *= 0.5f; side = 1; }
        else { hi = mid; chi = c; ghi = gm; if (side == -1) glo *= 0.5f; side = -1; }
      }
      if (!exact) {
        if (!conv) {
          unsigned klo = f2key(lo), khi = f2key(hi);
          while (khi - klo > 1u) {
            const unsigned km = klo + ((khi - klo) >> 1);
            const int c = count_ge(key2f(km));
            if (c == 256) { klo = km; exact = true; break; }
            if (c > 256) klo = km; else khi = km;
          }
          lo = key2f(klo);
        }
        T = lo;
      }
    }
    int need = 4096;
    if (!exact) {
      int cgt = 0;
#pragma unroll
      for (int c = 0; c < 4; ++c) if (c < nch) {
#pragma unroll
        for (int rr = 0; rr < 16; ++rr) cgt += (XS(c * 16 + rr) > T) ? 1 : 0;
      }
      need = 256 - wave_sum_i(cgt);
    }
    if (exact) {
#pragma unroll
      for (int c = 0; c < 4; ++c) if (c < nch) {
#pragma unroll
        for (int rr = 0; rr < 16; ++rr) { const int r = c * 16 + rr; const u64 w = __ballot(XS(r) >= T); if (lane == r) myword = w; }
      }
    } else
#pragma unroll
    for (int c = 0; c < 4; ++c) if (c < nch) {
#pragma unroll
      for (int rr = 0; rr < 16; ++rr) {
        const int r = c * 16 + rr;
        const u64 gt = __ballot(exact ? (XS(r) >= T) : (XS(r) > T));
        u64 eq = __ballot(!exact && XS(r) == T);
        if (eq) {
          int ne = __builtin_popcountll(eq);
          if (ne > need) { int drop = ne - need; while (drop-- > 0) eq &= ~(1ULL << (63 - __builtin_clzll(eq))); ne = need; }
          need -= ne;
        }
        const u64 w = gt | eq;
        if (lane == r) myword = w;
      }
    }
  }
  MASK[(size_t)tok * 64 + lane] = myword;
}

DI void phase_attn1(const Params& p, int layer, int bid, int nblk, char* smem) {
  const int lane = tidx() & 63, wid = __builtin_amdgcn_readfirstlane(tidx() >> 6);
  phase_cumsum(p, bid, nblk);
  for (int pr = bid; pr < 256; pr += nblk) { const int bh = pr & 31, i = pr >> 5;
#pragma unroll 1
    for (int k = 0; k < 2; ++k) sb_block(p, bh >> 2, bh & 3, k ? i : 15 - i, smem); }
  for (int pr = bid; pr < 256; pr += nblk) { const int b = pr & 7, i = pr >> 3;
#pragma unroll 1
    for (int k = 0; k < 2; ++k) {
      const int qb = k ? i : 63 - i;
      idx_block(p, b, qb, smem);
      __syncthreads();
#pragma unroll 1
      for (int j = 0; j < 8; ++j) dsa_select2(p, b * 4096 + qb * 64 + wid * 8 + j, lane);
    } }
  { float* tb = (float*)(smem + RING * ABUF + 64); __syncthreads(); build_bias_table(p, tb, 0);
    for (int it = bid; it < 256; it += nblk) swa_block(p, layer, it & 7, (it >> 3) & 1, it >> 4, smem, tb);
    __syncthreads(); }
}
DI void phase_attn2(const Params& p, int layer, int bid, int nblk, char* smem) {
  for (int pr = bid; pr < 256; pr += nblk) { const int bh = pr & 31, i = pr >> 5;
#pragma unroll 1
    for (int k = 0; k < 2; ++k) fox_block(p, bh >> 2, bh & 3, k ? i : 15 - i, smem); }
  __syncthreads();
  float* tb = (float*)(smem + RING * ABUF); build_bias_table(p, tb, 4);
  for (int pr = bid; pr < 256; pr += nblk) { const int b = pr & 7, i = pr >> 3;
#pragma unroll 1
    for (int k = 0; k < 2; ++k) dsa_block(p, b, k ? i : 63 - i, smem, tb); }
  __syncthreads();
}

DI void phase_gates(const Params& p, int layer, int bid, int nblk, char* smem) {
  char* wsq = opqp(p.ws);
  const bf16_t* hb = (const bf16_t*)(wsq + OFF_HB);
  const bf16_t* wt = (const bf16_t*)(wsq + OFF_WIN) + ((size_t)layer * 6912 + PW) * 1024;
  TILE_LOOP(128, 16, mt, nt) {
    f32x4 acc[8][4]; zero_acc(acc);
#if K8_GATES
    gemm_kloop8(acc, RowsDense{hb + (size_t)mt * 256 * DM, DM}, wt + (size_t)nt * 256 * DM, DM, DM, smem);
#else
    gemm_kloop<8>(acc, RowsDense{hb + (size_t)mt * 256 * DM, DM}, wt + (size_t)nt * 256 * DM, DM, DM, smem);
#endif
#pragma unroll
    for (int m = 0; m < 8; ++m)
#pragma unroll
      for (int n = 0; n < 4; ++n)
#pragma unroll
        for (int j = 0; j < 4; ++j) acc[m][n][j] = sigmoid_fast(acc[m][n][j]);
    const int t2 = tidx(), ln = t2 & 63, wid2 = t2 >> 6;
    unsigned char* G = (unsigned char*)(opqp(wsq) + OFF_R);
    unsigned char* gb = G + (size_t)(mt * 256 + (wid2 >> 2) * 128) * 4096 + nt * 256 + (wid2 & 3) * 64;
    store_tile_u8<8>(acc, smem, wid2, ln, [&](int row) { return gb + (size_t)row * 4096; });
#if K8_GATES
    k8_tile_end();
#endif
  }
}

DI void phase_merge(const Params& p, int layer, int bid, int nblk, char* smem) {
  char* wsq = opqp(p.ws);
  const bf16_t* O = (const bf16_t*)(wsq + OFF_O); const unsigned char* G = (const unsigned char*)(wsq + OFF_R);
  const bf16_t* wt = (const bf16_t*)(wsq + OFF_WBR) + (size_t)layer * 1024 * 1024;
  bf16_t* MG = (bf16_t*)(wsq + OFF_MG);
  constexpr int MST = 24576, MRING = 4;
  TILE_LOOP(256, 4, mt, nt) {
    const int tid = tidx(), wid = tid >> 6, lane = tid & 63, wr = wid >> 2, wc = wid & 3, fr = lane & 15, fq = lane >> 4;
    const int srow = tid >> 2, sg = ((srow >> 3) & 1) * 3, sch = (tid & 3) ^ sg;
    const bf16_t* asrc = O + (size_t)(mt * 128 + srow) * 1024 + sch * 8;
    const bf16_t* bsrc0 = wt + (size_t)(nt * 256 + srow) * 1024 + sch * 8;
    const bf16_t* bsrc1 = bsrc0 + (size_t)128 * 1024;
    auto stage = [&](int buf, int ks) {
      char* B = smem + buf * MST;
      glds16(asrc + ks * 32, B + tid * 16);
      glds16(bsrc0 + ks * 32, B + 8192 + tid * 16);
      glds16(bsrc1 + ks * 32, B + 16384 + tid * 16);
    };
    int aoff[4], boff[4];
#pragma unroll
    for (int m = 0; m < 4; ++m) { const int r = wr * 64 + m * 16 + fr; aoff[m] = r * 64 + ((fq ^ (((r >> 3) & 1) * 3)) << 4); }
#pragma unroll
    for (int n = 0; n < 4; ++n) { const int r = wc * 64 + n * 16 + fr; boff[n] = 8192 + r * 64 + ((fq ^ (((r >> 3) & 1) * 3)) << 4); }
    f32x4 macc[4][4]; zero_acc(macc);
    f32x4 acc[4][4]; zero_acc(acc);
    __syncthreads();
    stage(0, 0); stage(1, 1); stage(2, 2);
    ring_wait_barrier<3>(2);
#pragma unroll 1
    for (int ks = 0; ks < 32; ++ks) {
      if (ks + 3 < 32) stage((ks + 3) & (MRING - 1), ks + 3);
      const char* B = smem + (ks & (MRING - 1)) * MST;
      bf16x8 af[4], bfr[4];
#pragma unroll
      for (int n = 0; n < 4; ++n) bfr[n] = *(const bf16x8*)(B + boff[n]);
#pragma unroll
      for (int m = 0; m < 4; ++m) af[m] = *(const bf16x8*)(B + aoff[m]);
#pragma unroll
      for (int m = 0; m < 4; ++m)
#pragma unroll
        for (int n = 0; n < 4; ++n) acc[m][n] = __builtin_amdgcn_mfma_f32_16x16x32_bf16(bfr[n], af[m], acc[m][n], 0, 0, 0);
      if ((ks & 7) == 7) {
        const int b = ks >> 3;
        const unsigned char* gp = G + (size_t)(mt * 128 + wr * 64 + fr) * 4096 + b * 1024 + nt * 256 + wc * 64 + fq * 4;
        unsigned gv[4][4];
#pragma unroll
        for (int m = 0; m < 4; ++m)
#pragma unroll
          for (int n = 0; n < 4; ++n) gv[m][n] = *(const unsigned*)(gp + (size_t)m * 16 * 4096 + n * 16);
        __builtin_amdgcn_sched_barrier(0);
#pragma unroll
        for (int m = 0; m < 4; ++m)
#pragma unroll
          for (int n = 0; n < 4; ++n) {
            const unsigned g = gv[m][n];
            macc[m][n][0] += ((float)(g & 255u) * (1.f / 255.f)) * acc[m][n][0];
            macc[m][n][1] += ((float)((g >> 8) & 255u) * (1.f / 255.f)) * acc[m][n][1];
            macc[m][n][2] += ((float)((g >> 16) & 255u) * (1.f / 255.f)) * acc[m][n][2];
            macc[m][n][3] += ((float)(g >> 24) * (1.f / 255.f)) * acc[m][n][3];
            acc[m][n] = (f32x4){0.f, 0.f, 0.f, 0.f};
          }
      }
      if (ks + 1 < 32) ring_wait_barrier<3>((31 < ks + 3 ? 31 : ks + 3) - (ks + 1));
    }
    __syncthreads();
    {
      bf16_t* mb = MG + (size_t)(mt * 128 + wr * 64) * 1024 + nt * 256 + wc * 64;
      store_tile_bf16<4>(macc, smem, wid, lane, [&](int row) { return mb + (size_t)row * 1024; });
    }
  }
}

DI void phase_outproj(const Params& p, int layer, int bid, int nblk, char* smem) {
  char* wsq = opqp(p.ws);
  const bf16_t* MG = (const bf16_t*)(wsq + OFF_MG);
  const bf16_t* wt = (const bf16_t*)(wsq + OFF_WOUT) + (size_t)layer * 1024 * 1024;
  TILE_LOOP(128, 4, mt, nt) {
    f32x4 acc[8][4]; zero_acc(acc);
    gemm_kloop8(acc, RowsDense{MG + (size_t)mt * 256 * 1024, 1024}, wt + (size_t)nt * 256 * 1024, 1024, 1024, smem);
    const int t2 = tidx(), lane2 = t2 & 63, wid2 = t2 >> 6, wr = wid2 >> 2, wc = wid2 & 3, fr = lane2 & 15, fq = lane2 >> 4;
    float* out2 = opqp(p.out); const float* xin2 = layer == 0 ? opqp(p.x) : out2;
#pragma unroll
    for (int m = 0; m < 8; ++m) {
      const int tok = mt * 256 + wr * 128 + m * 16 + fr;
#pragma unroll
      for (int n = 0; n < 4; ++n) {
        const int col = nt * 256 + wc * 64 + n * 16 + fq * 4;
        f32x4 xv = *(const f32x4*)(xin2 + (size_t)tok * 1024 + col);
        *(f32x4*)(out2 + (size_t)tok * 1024 + col) = xv + acc[m][n];
      }
      __builtin_amdgcn_sched_barrier(0);
    }
    k8_tile_end();
  }
}

DI void phase_router2(const Params& p, int layer, int bid, int nblk, char* smem) {
  char* wsq = opqp(p.ws);
  const int lane = tidx() & 63, wid = __builtin_amdgcn_readfirstlane(tidx() >> 6), grp64 = wid >> 2, kw = wid & 3;
  phase_norm(p.out, p.norm_ffn_g + (size_t)layer * DM, (bf16_t*)(wsq + OFF_HB), bid, nblk);
  float* part = (float*)smem + grp64 * (4 * 37 * 64);
  int* TOKE = (int*)(wsq + OFF_TOKE); float* TOKG = (float*)(wsq + OFF_TOKG); int* TCNT = (int*)(wsq + OFF_TCNT);
  int* lcnt = (int*)(smem + 2 * 4 * 37 * 64 * 4);
  typedef const __attribute__((address_space(4))) float cfloat;
  cfloat* g = (cfloat*)(p.norm_ffn_g + (size_t)layer * DM + kw * 256);
  const float* wrg = p.w_rg + (size_t)layer * DM * 4; const float* wre = p.w_re + (size_t)layer * DM * 32;
  const int tid_ = tidx();
  for (int tile = bid; tile < NT / 128; tile += nblk) {
    const int tok = tile * 128 + grp64 * 64 + lane;
    const float* xr = p.out + (size_t)tok * DM + kw * 256;
    float acc[36]; float ss = 0.f;
#pragma unroll
    for (int e = 0; e < 36; ++e) acc[e] = 0.f;
#pragma unroll 1
    for (int hf = 0; hf < 2; ++hf) {
      __syncthreads();
#pragma unroll
      for (int i = 0; i < 9; ++i) {
        const int c = tid_ + 512 * i, kq = c / 1152, rem = c % 1152, k = rem / 9, j = rem % 9;
        const int kk = kq * 256 + hf * 128 + k;
        const float* src = (j < 8) ? (wre + (size_t)kk * 32 + 4 * j) : (wrg + (size_t)kk * 4);
        glds16(src, smem + c * 16);
      }
      asm volatile("s_waitcnt vmcnt(0)" ::: "memory");
      __syncthreads();
      const float* wimg = (const float*)smem + kw * 128 * 36;
#pragma unroll 1
      for (int k4 = 0; k4 < 128; k4 += 4) {
        const f32x4 xv = *(const f32x4*)(xr + hf * 128 + k4);
#pragma unroll
        for (int j = 0; j < 4; ++j) {
          const int k = k4 + j; const float x = xv[j]; ss += x * x; const float xg = x * g[hf * 128 + k];
          const float* wk = wimg + k * 36;
#pragma unroll
          for (int e4 = 0; e4 < 9; ++e4) {
            const f32x4 w = *(const f32x4*)(wk + 4 * e4);
#pragma unroll
            for (int e = 0; e < 4; ++e) acc[4 * e4 + e] += xg * w[e];
          }
        }
      }
    }
    __syncthreads();
    if (tidx() < 32) lcnt[tidx()] = 0;
#pragma unroll
    for (int e = 0; e < 36; ++e) part[(kw * 37 + e) * 64 + lane] = acc[e];
    part[(kw * 37 + 36) * 64 + lane] = ss;
    __syncthreads();
    if (kw == 0) {
      float lg[36];
#pragma unroll
      for (int e = 0; e < 36; ++e) lg[e] = (part[e * 64 + lane] + part[(37 + e) * 64 + lane]) + (part[(74 + e) * 64 + lane] + part[(111 + e) * 64 + lane]);
      const float sst = (part[36 * 64 + lane] + part[(37 + 36) * 64 + lane]) + (part[(74 + 36) * 64 + lane] + part[(111 + 36) * 64 + lane]);
      const float r = rsqrtf(sst * (1.f / DM) + 1e-6f);
#pragma unroll
      for (int e = 0; e < 32; ++e) lg[e] = lg[e] * r + p.b_re[layer * 32 + e];
#pragma unroll
      for (int e = 0; e < 4; ++e) lg[32 + e] = lg[32 + e] * r + p.b_rg[layer * 4 + e];
      int grp = 0; float gm = lg[32];
#pragma unroll
      for (int e = 1; e < 4; ++e) if (lg[32 + e] > gm) { gm = lg[32 + e]; grp = e; }
      float gs = 0.f;
#pragma unroll
      for (int e = 0; e < 4; ++e) gs += expf(lg[32 + e] - gm);
      const float p_grp = 1.f / gs;
      float ei[8];
#pragma unroll
      for (int j = 0; j < 8; ++j) ei[j] = grp == 0 ? lg[j] : (grp == 1 ? lg[8 + j] : (grp == 2 ? lg[16 + j] : lg[24 + j]));
      float em = ei[0];
#pragma unroll
      for (int j = 1; j < 8; ++j) em = fmaxf(em, ei[j]);
      float pe[8]; float es = 0.f;
#pragma unroll
      for (int j = 0; j < 8; ++j) { pe[j] = expf(ei[j] - em); es += pe[j]; }
#pragma unroll
      for (int j = 0; j < 8; ++j) pe[j] = pe[j] / es;
      int i0 = 0; float p0 = pe[0];
#pragma unroll
      for (int j = 1; j < 8; ++j) if (pe[j] > p0) { p0 = pe[j]; i0 = j; }
      int i1 = -1; float p1 = -1.f;
#pragma unroll
      for (int j = 0; j < 8; ++j) if (j != i0 && pe[j] > p1) { p1 = pe[j]; i1 = j; }
      const float den = p0 + p1;
      const int e0 = grp * 8 + i0, e1 = grp * 8 + i1;
      const int r0 = atomicAdd(&lcnt[e0], 1), r1 = atomicAdd(&lcnt[e1], 1);
      TOKE[tok * 2] = e0 | (r0 << 8); TOKE[tok * 2 + 1] = e1 | (r1 << 8);
      TOKG[tok * 2] = p_grp * p0 / den; TOKG[tok * 2 + 1] = p_grp * p1 / den;
    }
    __syncthreads();
    if (tidx() < 32) TCNT[tile * 32 + tidx()] = lcnt[tidx()];
  }
}

DI void load_expert_table(const Params& p, int layer, int* tab) {
  char* wsq = opqp(p.ws);
  const int* CNT = (const int*)(wsq + OFF_CNT) + layer * 64;
  if (tidx() == 0) {
    int acc = 0;
    for (int e = 0; e < 32; ++e) { int c = CNT[e]; int pad = (c + 255) / 256 * 256; tab[e] = acc; acc += pad; tab[32 + e] = acc; tab[64 + e] = c; }
  }
  __syncthreads();
}
DI void phase_slots(const Params& p, int layer, int bid, int nblk, char* smem) {
  char* wsq = opqp(p.ws);
  const int* TOKE = (const int*)(wsq + OFF_TOKE); const float* TOKG = (const float*)(wsq + OFF_TOKG); const int* TCNT = (const int*)(wsq + OFF_TCNT);
  int* CNT = (int*)(wsq + OFF_CNT) + layer * 64; int* SLT = (int*)(wsq + OFF_SLT); float* SLG = (float*)(wsq + OFF_SLG); int* TPOS = (int*)(wsq + OFF_TPOS);
  int* pre = (int*)smem;
  int* pst = pre + 256 * 32;
  const int t = tidx();
  for (int i = t; i < 256 * 32; i += NTHR) pre[i] = TCNT[i];
  __syncthreads();
  if (t < 32) { int run = 0; for (int tl = 0; tl < 256; ++tl) { const int c = pre[tl * 32 + t]; pre[tl * 32 + t] = run; run += c; } pst[32 + t] = run; }
  __syncthreads();
  if (t == 0) { int acc = 0; for (int e = 0; e < 32; ++e) { const int c = pst[32 + e]; pst[e] = acc; acc += (c + 255) / 256 * 256; } }
  __syncthreads();
  if (bid == 0 && t < 32) CNT[t] = pst[32 + t];
  for (int a = bid * NTHR + t; a < 2 * NT; a += nblk * NTHR) {
    const int v = TOKE[a], e = v & 255, rk = v >> 8, tile = a >> 8;
    const int pos = pst[e] + pre[tile * 32 + e] + rk;
    SLT[pos] = a >> 1; SLG[pos] = TOKG[a]; TPOS[a] = pos;
  }
  __syncthreads();
}

struct RowsGather { const bf16_t* base; const int* slt; int slot0; int nvalid; DI const bf16_t* operator()(int r) const { int tok = (r < nvalid) ? slt[slot0 + r] : 0; return base + (size_t)tok * DM; } DI unsigned off(int r) const { int tok = (r < nvalid) ? slt[slot0 + r] : 0; return (unsigned)tok * (unsigned)DM; } static constexpr bool kDense = false; };
DI void phase_up(const Params& p, int layer, int bid, int nblk, char* smem) {
  char* wsq = opqp(p.ws);
  int* tab = (int*)(smem + 2 * GSTAGE); load_expert_table(p, layer, tab);
  const bf16_t* hb = (const bf16_t*)(wsq + OFF_HB); const int* SLT = (const int*)(wsq + OFF_SLT);
  const bf16_t* wt = (const bf16_t*)(wsq + OFF_UP) + (size_t)layer * 32 * 1024 * 1024;
  const int ntiles_m = tab[63] / 256;
  TILE_LOOP(ntiles_m, 4, mt, nt) {
    const int slot0 = mt * 256;
    int e = 0;
    for (int k = 0; k < 32; ++k) if (slot0 >= tab[32 + k]) e = k + 1;
    const int nvalid = tab[e] + tab[64 + e] - slot0;
    f32x4 acc[8][4]; zero_acc(acc);
#if K8_UP
    gemm_kloop8(acc, RowsGather{hb, SLT, slot0, nvalid}, wt + ((size_t)e * 1024 + nt * 256) * 1024, 1024, 1024, smem);
#else
    gemm_kloop<8>(acc, RowsGather{hb, SLT, slot0, nvalid}, wt + ((size_t)e * 1024 + nt * 256) * 1024, 1024, 1024, smem);
#endif
    const int t2 = tidx(), lane = t2 & 63, wid = t2 >> 6, wr = wid >> 2, wc = wid & 3;
    bf16_t* ACT = (bf16_t*)(opqp(wsq) + OFF_ACT);
    f32x4 av[8][2];
#pragma unroll
    for (int m = 0; m < 8; ++m)
#pragma unroll
      for (int n2 = 0; n2 < 2; ++n2) {
        const f32x4 gv = acc[m][2 * n2], uv = acc[m][2 * n2 + 1];
#pragma unroll
        for (int j = 0; j < 4; ++j) av[m][n2][j] = gv[j] * sigmoid_fast(gv[j]) * uv[j];
      }
    {
      const int ln = opq(lane);
      bf16_t* ab = ACT + (size_t)(slot0 + wr * 128) * EFF + nt * 128 + wc * 32;
      store_tile_bf16_32<8>(av, smem, wid, ln, [&](int row) { return ab + (size_t)row * EFF; });
    }
    k8_tile_end();
  }
  __syncthreads();
}
DI void phase_down(const Params& p, int layer, int bid, int nblk, char* smem) {
  char* wsq = opqp(p.ws);
  int* tab = (int*)(smem + 2 * GSTAGE); load_expert_table(p, layer, tab);
  const bf16_t* ACT = (const bf16_t*)(wsq + OFF_ACT);
  const bf16_t* wt = (const bf16_t*)(wsq + OFF_DOWN) + (size_t)layer * 32 * 1024 * 512;
  const int ntiles_m = tab[63] / 256;
  TILE_LOOP(ntiles_m, 4, mt, nt) {
    const int slot0 = mt * 256;
    int e = 0;
    for (int k = 0; k < 32; ++k) if (slot0 >= tab[32 + k]) e = k + 1;
    f32x4 acc[8][4]; zero_acc(acc);
    gemm_kloop8(acc, RowsDense{ACT + (size_t)slot0 * EFF, EFF}, wt + ((size_t)e * 1024 + nt * 256) * 512, 512, 512, smem);
    const int t2 = tidx(), lane = t2 & 63, wid = t2 >> 6, wr = wid >> 2, wc = wid & 3;
    bf16_t* Y = (bf16_t*)(opqp(wsq) + OFF_Y);
    {
      const int ln = opq(lane);
      bf16_t* yb = Y + (size_t)(slot0 + wr * 128) * 1024 + nt * 256 + wc * 64;
      store_tile_bf16<8>(acc, smem, wid, ln, [&](int row) { return yb + (size_t)row * 1024; });
    }
    k8_tile_end();
  }
  __syncthreads();
}
DI void phase_combine(const Params& p, int layer, int bid, int nblk) {
  char* wsq = opqp(p.ws);
  const bf16_t* Y = (const bf16_t*)(wsq + OFF_Y); const int* TPOS = (const int*)(wsq + OFF_TPOS); const float* TOKG = (const float*)(wsq + OFF_TOKG);
  bf16_t* hb = (bf16_t*)(wsq + OFF_HB); const float* gn = p.norm_mix_g + DM;
  const int lane = tidx() & 63, wid = tidx() >> 6;
  for (int tok = bid * NWV + wid; tok < NT; tok += nblk * NWV) {
    const int p0 = TPOS[tok * 2], p1 = TPOS[tok * 2 + 1]; const float g0 = TOKG[tok * 2], g1 = TOKG[tok * 2 + 1];
    f32x4 xo[4]; float ss = 0.f;
#pragma unroll
    for (int i = 0; i < 4; ++i) {
      const int c = lane * 4 + 256 * i;
      f32x4 xv = *(const f32x4*)(p.out + (size_t)tok * DM + c);
      const u32x2 a = *(const u32x2*)(Y + (size_t)p0 * DM + c), bq = *(const u32x2*)(Y + (size_t)p1 * DM + c);
      f32x4 y0 = {__uint_as_float(a[0] << 16), __uint_as_float(a[0] & 0xffff0000u), __uint_as_float(a[1] << 16), __uint_as_float(a[1] & 0xffff0000u)};
      f32x4 y1 = {__uint_as_float(bq[0] << 16), __uint_as_float(bq[0] & 0xffff0000u), __uint_as_float(bq[1] << 16), __uint_as_float(bq[1] & 0xffff0000u)};
      xo[i] = xv + (y0 * g0 + y1 * g1);
      *(f32x4*)(p.out + (size_t)tok * DM + c) = xo[i];
      ss += xo[i][0] * xo[i][0] + xo[i][1] * xo[i][1] + xo[i][2] * xo[i][2] + xo[i][3] * xo[i][3];
    }
    if (layer == 0) {
      ss = wave_sum(ss);
      const float r = rsqrtf(ss * (1.f / DM) + 1e-6f);
#pragma unroll
      for (int i = 0; i < 4; ++i) {
        const f32x4 gg = *(const f32x4*)(gn + lane * 4 + 256 * i);
        u32x2 o; o[0] = pack2(xo[i][0] * r * gg[0], xo[i][1] * r * gg[1]); o[1] = pack2(xo[i][2] * r * gg[2], xo[i][3] * r * gg[3]);
        *(u32x2*)(hb + (size_t)tok * DM + lane * 4 + 256 * i) = o;
      }
    }
  }
}

#define XB_TMO      128
#define XB_XCNT(j)  (256  + 64 * (j))
#define XB_XSUB(j)  (1280 + 64 * (j))
#define XB_XGEN(j)  (2304 + 64 * (j))
#define XB_TOP      3328
#define XB_TOPGEN   3392
#define XCD_BAR_WORDS 3456
#define XB_SPIN_CAP (1u << 20)
#define LAS __attribute__((address_space(3)))
DI unsigned xb_ld(unsigned* p)              { return __hip_atomic_load(p, __ATOMIC_RELAXED, __HIP_MEMORY_SCOPE_AGENT); }
DI unsigned xb_add(unsigned* p, unsigned v) { return __hip_atomic_fetch_add(p, v, __ATOMIC_RELAXED, __HIP_MEMORY_SCOPE_AGENT); }
DI unsigned xb_xcc_id() { return (unsigned)__builtin_amdgcn_s_getreg((3 << 11) | 20) & 0xFu; }
#define XB_SPIN(cond, bar) do { unsigned _sp = 0; while (cond) { __builtin_amdgcn_s_sleep(1); \
    if ((++_sp & 255u) == 0u) { if (xb_ld(&(bar)[XB_TMO])) break; if (_sp > XB_SPIN_CAP) { atomicAdd(&(bar)[XB_TMO], 1u); break; } } } } while (0)
struct XcdBarrier { unsigned* bar; unsigned x; volatile LAS unsigned* st; };
DI XcdBarrier xcd_barrier_post(unsigned* bar, volatile LAS unsigned* st) {
  XcdBarrier b; b.bar = bar; b.x = xb_xcc_id(); b.st = st;
  if (threadIdx.x == 0) (void)xb_add(&bar[XB_XCNT(b.x)], 1u);
  return b;
}
DI void xcd_barrier_complete(unsigned* bar, unsigned x, unsigned& nloc, unsigned& nx) {
  const unsigned G = gridDim.x * gridDim.y * gridDim.z;
  unsigned sum, cnt, mine, sp = 0u;
  for (;;) {
    sum = 0u; cnt = 0u; mine = 0u;
#pragma unroll
    for (unsigned j = 0; j < 16; ++j) { const unsigned c = xb_ld(&bar[XB_XCNT(j)]); sum += c; cnt += (c > 0u) ? 1u : 0u; mine = (j == x) ? c : mine; }
    if (sum == G) break;
    __builtin_amdgcn_s_sleep(1);
    if ((++sp & 255u) == 0u) { if (xb_ld(&bar[XB_TMO])) break; if (sp > XB_SPIN_CAP) { atomicAdd(&bar[XB_TMO], 1u); break; } }
  }
  nloc = mine > 0u ? mine : 1u; nx = cnt > 0u ? cnt : 1u;
}
DI void xcd_barrier(const XcdBarrier& b) {
  asm volatile("s_waitcnt vmcnt(0)" ::: "memory");
  __syncthreads();
  if (threadIdx.x == 0) {
    unsigned* bar = opqp(b.bar);
    __builtin_amdgcn_s_waitcnt(0);
    unsigned nloc = b.st[0], nx = b.st[1];
    if (nloc == 0u) { xcd_barrier_complete(bar, b.x, nloc, nx); b.st[0] = nloc; b.st[1] = nx; }
    const unsigned old = xb_add(&bar[XB_XSUB(b.x)], 1u);
    const unsigned gen = old / nloc;
    if (old + 1u == (gen + 1u) * nloc) {
      __builtin_amdgcn_fence(__ATOMIC_RELEASE, "agent");
      asm volatile("s_waitcnt vmcnt(0)" ::: "memory");
      const unsigned og = xb_add(&bar[XB_TOP], 1u);
      const unsigned tg = og / nx;
      if (og + 1u == (tg + 1u) * nx) xb_add(&bar[XB_TOPGEN], 1u);
      else XB_SPIN(xb_ld(&bar[XB_TOPGEN]) == tg, bar);
      __builtin_amdgcn_fence(__ATOMIC_ACQUIRE, "agent");
      xb_add(&bar[XB_XGEN(b.x)], 1u);
      asm volatile("s_waitcnt vmcnt(0)" ::: "memory");
    } else {
      XB_SPIN(xb_ld(&bar[XB_XGEN(b.x)]) == gen, bar);
      __builtin_amdgcn_fence(__ATOMIC_ACQUIRE, "agent");
      asm volatile("s_waitcnt vmcnt(0)" ::: "memory");
    }
  }
  __syncthreads();
}

namespace cg = cooperative_groups;
__global__ void __launch_bounds__(512, 2) mega(Params p) {
  __shared__ __attribute__((aligned(16))) char smem[2 * GSTAGE + 512];
  cg::grid_group grid = cg::this_grid();
  const int bid = blockIdx.x, nblk = gridDim.x;
  unsigned* bar = (unsigned*)(p.ws + OFF_BAR);
  volatile LAS unsigned* xst = (volatile LAS unsigned*)(smem + 2 * GSTAGE + 448);
  if (bid == 0) for (int i = threadIdx.x; i < XCD_BAR_WORDS; i += NTHR) bar[i] = 0u;
  if (threadIdx.x == 0) { xst[0] = 0u; xst[1] = 0u; }
  for (int rep = 0; rep < 1 + PROBE_CV; ++rep) {
  phase_convert(p, bid, nblk, smem);
  phase_norm(p.x, p.norm_mix_g, (bf16_t*)(p.ws + OFF_HB), bid, nblk);
  grid.sync();
  }
  const XcdBarrier xb = xcd_barrier_post(bar, xst);
#define GS() xcd_barrier(xb)
#pragma unroll 1
  for (int layer = 0; layer < 2; ++layer) {
    for (int rep = 0; rep < 1 + PROBE_GEMM; ++rep) { phase_inproj(p, layer, bid, nblk, smem); GS(); }
    for (int rep = 0; rep < 1 + PROBE_A1; ++rep) { phase_attn1(p, layer, bid, nblk, smem); GS(); }
    for (int rep = 0; rep < 1 + PROBE_A2; ++rep) { phase_attn2(p, layer, bid, nblk, smem); GS(); }
    for (int rep = 0; rep < 1 + PROBE_GEMM; ++rep) { phase_gates(p, layer, bid, nblk, smem); GS(); }
    for (int rep = 0; rep < 1 + PROBE_GEMM; ++rep) { phase_merge(p, layer, bid, nblk, smem); GS(); }
    phase_outproj(p, layer, bid, nblk, smem); GS();
    phase_router2(p, layer, bid, nblk, smem); GS();
    phase_slots(p, layer, bid, nblk, smem); GS();
    for (int rep = 0; rep < 1 + PROBE_GEMM; ++rep) { phase_up(p, layer, bid, nblk, smem); GS(); }
    for (int rep = 0; rep < 1 + PROBE_GEMM; ++rep) { phase_down(p, layer, bid, nblk, smem); GS(); }
    phase_combine(p, layer, bid, nblk);
    if (layer == 0) GS();
  }
}

#ifdef PHASE_TEST
template <int PH> __global__ void __launch_bounds__(512, 2) k_phase(Params p, int layer) {
  __shared__ __attribute__((aligned(16))) char smem[2 * GSTAGE + 512];
  const int bid = blockIdx.x, nblk = gridDim.x;
  if (PH == 0) phase_convert(p, bid, nblk, smem);
  if (PH == 1) phase_norm(p.x, p.norm_mix_g, (bf16_t*)(p.ws + OFF_HB), bid, nblk);
  if (PH == 2) phase_inproj(p, layer, bid, nblk, smem);
  if (PH == 3) phase_attn1(p, layer, bid, nblk, smem);
  if (PH == 4) phase_attn2(p, layer, bid, nblk, smem);
  if (PH == 6) phase_gates(p, layer, bid, nblk, smem);
  if (PH == 7) phase_merge(p, layer, bid, nblk, smem);
  if (PH == 8) phase_outproj(p, layer, bid, nblk, smem);
  if (PH == 9) phase_router2(p, layer, bid, nblk, smem);
  if (PH == 10) phase_slots(p, layer, bid, nblk, smem);
  if (PH == 11) phase_up(p, layer, bid, nblk, smem);
  if (PH == 12) phase_down(p, layer, bid, nblk, smem);
  if (PH == 13) phase_combine(p, layer, bid, nblk);
  if (PH == 14) sb_block(p, bid & 7, bid & 3, bid & 15, smem);
  if (PH == 15) idx_block(p, bid & 7, bid & 63, smem);
  if (PH == 16) fast_swa(p, layer, bid & 7, bid & 3, bid & 127, tidx() & 63, (float*)smem);
  if (PH == 17) fox_block(p, bid & 7, bid & 3, bid & 15, smem);
  if (PH == 18) dsa_block(p, bid & 7, bid & 63, smem, (float*)smem + 10000);
  if (PH == 19) dsa_select2(p, bid, tidx() & 63);
}
template __global__ void k_phase<14>(Params, int); template __global__ void k_phase<15>(Params, int); template __global__ void k_phase<16>(Params, int);
template __global__ void k_phase<17>(Params, int); template __global__ void k_phase<18>(Params, int); template __global__ void k_phase<19>(Params, int);
template __global__ void k_phase<0>(Params, int); template __global__ void k_phase<1>(Params, int); template __global__ void k_phase<2>(Params, int);
template __global__ void k_phase<3>(Params, int); template __global__ void k_phase<4>(Params, int); template __global__ void k_phase<5>(Params, int);
template __global__ void k_phase<6>(Params, int); template __global__ void k_phase<7>(Params, int); template __global__ void k_phase<8>(Params, int);
template __global__ void k_phase<9>(Params, int); template __global__ void k_phase<10>(Params, int); template __global__ void k_phase<11>(Params, int);
template __global__ void k_phase<12>(Params, int); template __global__ void k_phase<13>(Params, int);
#endif

extern "C" void kernel_launch(void* const* d_in, const int* in_sizes, int n_in, void* d_out, int out_size, void* d_ws, size_t ws_size,
                              hipStream_t stream) {
  Params p{};
  p.x = (const float*)d_in[0]; p.norm_mix_g = (const float*)d_in[1]; p.w_in = (const float*)d_in[2]; p.forget_bias = (const float*)d_in[3];
  p.attn_sinks = (const float*)d_in[4]; p.qk_gain = (const float*)d_in[5]; p.w_branch = (const float*)d_in[6]; p.w_out = (const float*)d_in[7];
  p.t5 = (const float*)d_in[8]; p.norm_ffn_g = (const float*)d_in[9]; p.w_rg = (const float*)d_in[10]; p.b_rg = (const float*)d_in[11];
  p.w_re = (const float*)d_in[12]; p.b_re = (const float*)d_in[13]; p.w_up = (const float*)d_in[14]; p.w_down = (const float*)d_in[15];
  p.out = (float*)d_out; p.ws = (char*)d_ws;
  if (ws_size < WS_END) { fprintf(stderr, "workspace too small: %zu < %zu\n", ws_size, (size_t)WS_END); return; }
  static int grid_blocks = 0;
  if (!grid_blocks) {
    int dev = 0, cus = 0, per_cu = 0;
    hipGetDevice(&dev);
    hipDeviceGetAttribute(&cus, hipDeviceAttributeMultiprocessorCount, dev);
    hipOccupancyMaxActiveBlocksPerMultiprocessor(&per_cu, mega, NTHR, 0);
    if (per_cu > 1) per_cu = 1;
    if (per_cu < 1) per_cu = 1;
    grid_blocks = cus * per_cu;
  }
  void* args[] = {&p};
  hipError_t e = hipLaunchCooperativeKernel((void*)mega, dim3(grid_blocks), dim3(NTHR), args, 0, stream);
  if (e != hipSuccess) fprintf(stderr, "cooperative launch failed: %s (grid %d)\n", hipGetErrorString(e), grid_blocks);
}
```

```cpp
#include <hip/hip_runtime.h>
#include <hip/hip_cooperative_groups.h>
#include <stdint.h>
#include <stdio.h>

typedef unsigned short bf16_t;
typedef short bf16x8 __attribute__((ext_vector_type(8)));
typedef float f32x4 __attribute__((ext_vector_type(4)));
typedef unsigned u32x4 __attribute__((ext_vector_type(4)));
typedef unsigned u32x2 __attribute__((ext_vector_type(2)));
typedef unsigned long long u64;

#define DI __device__ __forceinline__
#ifndef FAST_SWA
#define FAST_SWA 1
#endif
#ifndef FAST_FOX
#define FAST_FOX 1
#endif
#ifndef FAST_SB
#define FAST_SB 1
#endif
#ifndef FAST_DSA
#define FAST_DSA 1
#endif
#ifndef FAST_IDX
#define FAST_IDX 1
#endif
#define PROBE_GEMM 0
#define PROBE_A1 0
#define PROBE_A2 0
#define PROBE_A3 0
#define PROBE_CV 0
#define LOG2E 1.4426950408889634f
#define QS_SWA (FAST_SWA ? 0.125f * LOG2E : 0.125f)
#define QS_FOX (FAST_FOX ? 0.125f * LOG2E : 0.125f)
#define QS_SB (FAST_SB ? 0.125f * LOG2E : 0.125f)
#define QS_DSA (FAST_DSA ? 0.125f * LOG2E : 0.125f)

constexpr int NB = 8, SEQ = 4096, NT = NB * SEQ, DM = 1024;
constexpr int INC = 6856;
constexpr int PW = 2816;
constexpr int NEXP = 32, EFF = 512;
constexpr int NSLOT = 2 * NT + NEXP * 256;
constexpr int NTHR = 512, NWV = 8;
constexpr int U_AQ = 0, U_AK = 4, U_AV = 6, U_FQ = 8, U_FK = 12, U_FV = 16, U_SQ = 20, U_SK = 24, U_SV = 28,
              U_DQ = 32, U_DK = 36, U_DV = 37, U_IQ = 38, U_IK = 42, U_SM = 43;
constexpr long SC_PER_B = 1024L * 8256L;

constexpr size_t AL(size_t x) { return (x + 255) & ~(size_t)255; }
constexpr size_t OFF_WIN = 0;
constexpr size_t OFF_WBR = OFF_WIN + AL(2UL * 6912 * 1024 * 2);
constexpr size_t OFF_WOUT = OFF_WBR + AL(2UL * 4 * 1024 * 256 * 2);
constexpr size_t OFF_UP = OFF_WOUT + AL(2UL * 1024 * 1024 * 2);
constexpr size_t OFF_DOWN = OFF_UP + AL(2UL * 32 * 1024 * 1024 * 2);
constexpr size_t OFF_HB = OFF_DOWN + AL(2UL * 32 * 1024 * 512 * 2);
constexpr size_t OFF_P = OFF_HB + AL((size_t)NT * 1024 * 2);
constexpr size_t OFF_MG = OFF_P;
constexpr size_t OFF_ACT = OFF_P + AL((size_t)NT * 1024 * 2);
constexpr size_t OFF_VT = OFF_P + AL((size_t)NT * PW * 2);
constexpr size_t OFF_LOGF = OFF_VT + AL(8UL * 11 * 64 * 4096 * 2);
constexpr size_t OFF_CT = OFF_LOGF + AL((size_t)NT * 4 * 4);
constexpr size_t OFF_IW = OFF_CT + AL((size_t)NT * 4 * 4);
constexpr size_t OFF_R = OFF_IW + AL((size_t)NT * 4 * 4);
constexpr size_t OFF_Y = OFF_R;
constexpr size_t OFF_O = OFF_R + AL((size_t)NSLOT * 1024 * 4);
constexpr size_t OFF_MASK = OFF_O + AL((size_t)NT * 1024 * 2);
constexpr size_t OFF_TOKE = OFF_MASK + AL((size_t)NT * 512);
constexpr size_t OFF_TOKG = OFF_TOKE + AL((size_t)NT * 8);
constexpr size_t OFF_SLT = OFF_TOKG + AL((size_t)NT * 8);
constexpr size_t OFF_SLG = OFF_SLT + AL((size_t)NSLOT * 4);
constexpr size_t OFF_CNT = OFF_SLG + AL((size_t)NSLOT * 4);
constexpr size_t OFF_TPOS = OFF_CNT + 1024;
constexpr size_t OFF_TCNT = OFF_TPOS + AL((size_t)NT * 8);
constexpr size_t OFF_BAR = OFF_TCNT + AL(256UL * 32 * 4);
constexpr size_t WS_END = OFF_BAR + 16384;
static_assert(8UL * SC_PER_B * 4 <= (size_t)NSLOT * 1024 * 4, "R region");
static_assert(WS_END <= (1UL << 30), "workspace");

struct Params {
  const float* x; const float* norm_mix_g; const float* w_in; const float* forget_bias; const float* attn_sinks;
  const float* qk_gain; const float* w_branch; const float* w_out; const float* t5; const float* norm_ffn_g;
  const float* w_rg; const float* b_rg; const float* w_re; const float* b_re; const float* w_up; const float* w_down;
  float* out; char* ws;
};

DI int opq(int x) { asm volatile("" : "+v"(x)); return x; }
template <class T> DI T* opqp(T* q) { asm volatile("" : "+s"(q)); return q; }
DI int tidx() { int x = __builtin_amdgcn_workitem_id_x(); asm volatile("" : "+v"(x)); return x; }
DI int perm256(int g) { return ((g >> 5) & 3) * 64 + (g >> 7) * 32 + (g & 31); }
DI int perm32(int c) { return ((c >> 2) & 1) * 16 + ((c >> 4) & 1) * 8 + ((c >> 3) & 1) * 4 + (c & 3); }
DI float bf2f(bf16_t v) { return __uint_as_float(((unsigned)v) << 16); }
DI bf16_t f2bf(float f) { unsigned u = __float_as_uint(f); u += 0x7fffu + ((u >> 16) & 1u); return (bf16_t)(u >> 16); }
typedef __bf16 hbf16x2 __attribute__((ext_vector_type(2)));
typedef float f32x2 __attribute__((ext_vector_type(2)));
DI unsigned pack2(float lo, float hi) { f32x2 v = {lo, hi}; return __builtin_bit_cast(unsigned, __builtin_convertvector(v, hbf16x2)); }
DI float wave_sum(float v) { for (int o = 32; o > 0; o >>= 1) v += __shfl_xor(v, o); return v; }
DI float wave_max(float v) { for (int o = 32; o > 0; o >>= 1) v = fmaxf(v, __shfl_xor(v, o)); return v; }
DI float sigmoid_fast(float v) { return __builtin_amdgcn_rcpf(1.f + __builtin_amdgcn_exp2f(-v * 1.4426950408889634f)); }
DI float log_sigmoid_f(float x) { return fminf(x, 0.f) - 0.6931471805599453f * __builtin_amdgcn_logf(1.f + __builtin_amdgcn_exp2f(-fabsf(x) * 1.4426950408889634f)); }

__device__ const unsigned char T5B[128] = {
  0, 1, 2, 3, 4, 5, 6, 7, 8, 9, 10, 11, 12, 13, 14, 15, 16, 16, 16, 17, 17, 18, 18, 18, 19, 19, 19, 20, 20, 20, 20, 21,
  21, 21, 21, 22, 22, 22, 22, 22, 23, 23, 23, 23, 23, 23, 24, 24, 24, 24, 24, 24, 25, 25, 25, 25, 25, 25, 25, 26, 26, 26, 26, 26,
  26, 26, 26, 27, 27, 27, 27, 27, 27, 27, 27, 27, 27, 28, 28, 28, 28, 28, 28, 28, 28, 28, 28, 29, 29, 29, 29, 29, 29, 29, 29, 29,
  29, 29, 29, 30, 30, 30, 30, 30, 30, 30, 30, 30, 30, 30, 30, 30, 30, 31, 31, 31, 31, 31, 31, 31, 31, 31, 31, 31, 31, 31, 31, 31};
DI int t5_bucket(int dist) { return T5B[dist > 127 ? 127 : dist]; }

DI void load_row64(const bf16_t* p, float* q) {
#pragma unroll
  for (int i = 0; i < 8; ++i) {
    u32x4 v = *(const u32x4*)(p + i * 8);
#pragma unroll
    for (int j = 0; j < 4; ++j) { q[i * 8 + 2 * j] = __uint_as_float(v[j] << 16); q[i * 8 + 2 * j + 1] = __uint_as_float(v[j] & 0xffff0000u); }
  }
}
DI float dot_row64(const bf16_t* p, const float* q) {
  float acc = 0.f;
#pragma unroll
  for (int i = 0; i < 8; ++i) {
    u32x4 v = *(const u32x4*)(p + i * 8);
#pragma unroll
    for (int j = 0; j < 4; ++j) { acc += q[i * 8 + 2 * j] * __uint_as_float(v[j] << 16); acc += q[i * 8 + 2 * j + 1] * __uint_as_float(v[j] & 0xffff0000u); }
  }
  return acc;
}

#define K8_GATES 1
#define K8_INPROJ 1
#define K8_OUT 1
#define K8_UP 1
#define K8_DOWN 1
DI int colmap(int mode, int n) {
  if (mode == 4) { n = (n & ~255) + perm256(n & 255); mode = 0; }
  if (mode == 5) { n = (n & ~255) + perm256(n & 255); mode = 2; }
  if (mode == 1) { if ((n >= 2816 && K8_GATES) || (n < 2816 && K8_INPROJ)) n = (n & ~255) + perm256(n & 255); }
  if (mode == 0) return n;
  if (mode == 1) {
    if (n < 1280) return n;
    if (n < 2752) return n + 4;
    if (n < 2756) return 1280 + (n - 2752);
    if (n < 2760) return n;
    if (n < 2816) return -1;
    return n - 56;
  }
  int blk = n >> 5, w = n & 31;
  return (w < 16) ? (blk * 16 + w) : (512 + blk * 16 + (w - 16));
}
struct CvItem { const float* src; bf16_t* dst; int Nsrc, K, n0, k0, mode; };
DI void cv_load(const CvItem& c, f32x4 (&v)[8]) {
  const int t = tidx();
  const int n4 = (t & 15) * 4, kr = t >> 4;
  const int col = colmap(c.mode, c.n0 + n4);
#pragma unroll
  for (int i = 0; i < 8; ++i) { v[i] = (f32x4){0.f, 0.f, 0.f, 0.f}; if (col >= 0) v[i] = *(const f32x4*)(c.src + (size_t)(c.k0 + kr + 32 * i) * c.Nsrc + col); }
}
DI void cv_store(const CvItem& c, const f32x4 (&v)[8], float (*tile)[65]) {
  const int t = tidx();
  const int n4 = (t & 15) * 4, kr = t >> 4;
#pragma unroll
  for (int i = 0; i < 8; ++i) { const int kk = kr + 32 * i; tile[kk][n4] = v[i][0]; tile[kk][n4 + 1] = v[i][1]; tile[kk][n4 + 2] = v[i][2]; tile[kk][n4 + 3] = v[i][3]; }
  __syncthreads();
  const int nn = t >> 3;
#pragma unroll
  for (int q = 0; q < 4; ++q) {
    const int k8 = (t & 7) * 8 + 64 * q;
    u32x4 o;
#pragma unroll
    for (int j = 0; j < 4; ++j) o[j] = pack2(tile[k8 + 2 * j][nn], tile[k8 + 2 * j + 1][nn]);
    *(u32x4*)(c.dst + (size_t)(c.n0 + nn) * c.K + c.k0 + k8) = o;
  }
  __syncthreads();
}
constexpr int T_IN = 108 * 4, T_BR = 4 * 16, T_OUT = 16 * 4, T_UP = 32 * 16 * 4, T_DN = 32 * 16 * 2;
constexpr int T_LAYER = T_IN + T_BR + T_OUT + T_UP + T_DN;
DI CvItem cv_decode(const Params& p, char* wsq, int it) {
  int l = it / T_LAYER, r = it % T_LAYER;
  CvItem c;
  if (r < T_IN) {
    int nt = r / 4, kt = r % 4;
    c = CvItem{p.w_in + (size_t)l * 1024 * INC, (bf16_t*)(wsq + OFF_WIN) + (size_t)l * 6912 * 1024, INC, 1024, nt * 64, kt * 256, 1};
  } else if ((r -= T_IN) < T_BR) {
    int b = r / 16, nt = r % 16;
    c = CvItem{p.w_branch + (size_t)l * 1024 * 1024, (bf16_t*)(wsq + OFF_WBR) + (size_t)l * 1024 * 1024, 1024, 1024, nt * 64, b * 256, 0};
  } else if ((r -= T_BR) < T_OUT) {
    int nt = r / 4, kt = r % 4;
    c = CvItem{p.w_out + (size_t)l * 1024 * 1024, (bf16_t*)(wsq + OFF_WOUT) + (size_t)l * 1024 * 1024, 1024, 1024, nt * 64, kt * 256, K8_OUT ? 4 : 0};
  } else if ((r -= T_OUT) < T_UP) {
    int e = r / 64, q = r % 64, nt = q / 4, kt = q % 4;
    c = CvItem{p.w_up + ((size_t)l * 32 + e) * 1024 * 1024, (bf16_t*)(wsq + OFF_UP) + ((size_t)l * 32 + e) * 1024 * 1024, 1024, 1024, nt * 64, kt * 256, K8_UP ? 5 : 2};
  } else {
    r -= T_UP;
    int e = r / 32, q = r % 32, nt = q / 2, kt = q % 2;
    c = CvItem{p.w_down + ((size_t)l * 32 + e) * 512 * 1024, (bf16_t*)(wsq + OFF_DOWN) + ((size_t)l * 32 + e) * 1024 * 512, 1024, 512, nt * 64, kt * 256, K8_DOWN ? 4 : 0};
  }
  return c;
}
DI void phase_convert(const Params& p, int bid, int nblk, char* smem) {
  char* wsq = opqp(p.ws);
  float (*tile)[65] = (float (*)[65])smem;
  int it = bid;
  if (it < 2 * T_LAYER) {
    CvItem c = cv_decode(p, wsq, it);
    f32x4 v[8], w[8];
    cv_load(c, v);
#pragma unroll 1
    for (; it < 2 * T_LAYER; it += nblk) {
      const bool more = it + nblk < 2 * T_LAYER;
      CvItem cn = c;
      if (more) { cn = cv_decode(p, wsq, it + nblk); cv_load(cn, w); }
      cv_store(c, v, tile);
      c = cn;
#pragma unroll
      for (int i = 0; i < 8; ++i) v[i] = w[i];
    }
  }
  if (bid == 0 && tidx() < 128) ((int*)(wsq + OFF_CNT))[tidx()] = 0;
}

DI void phase_norm(const float* __restrict__ xin, const float* __restrict__ g, bf16_t* __restrict__ hb, int bid, int nblk) {
  const int lane = tidx() & 63, wid = tidx() >> 6;
  for (int row = bid * NWV + wid; row < NT; row += nblk * NWV) {
    const float* xr = xin + (size_t)row * DM;
    f32x4 v[4]; float ss = 0.f;
#pragma unroll
    for (int i = 0; i < 4; ++i) { v[i] = *(const f32x4*)(xr + lane * 4 + 256 * i); ss += v[i][0] * v[i][0] + v[i][1] * v[i][1] + v[i][2] * v[i][2] + v[i][3] * v[i][3]; }
    ss = wave_sum(ss);
    const float r = rsqrtf(ss * (1.f / DM) + 1e-6f);
#pragma unroll
    for (int i = 0; i < 4; ++i) {
      f32x4 gg = *(const f32x4*)(g + lane * 4 + 256 * i);
      u32x2 o; o[0] = pack2(v[i][0] * r * gg[0], v[i][1] * r * gg[1]); o[1] = pack2(v[i][2] * r * gg[2], v[i][3] * r * gg[3]);
      *(u32x2*)(hb + (size_t)row * DM + lane * 4 + 256 * i) = o;
    }
  }
}

typedef __attribute__((address_space(3))) void* lds_ptr_t;
constexpr int GSTAGE = 65536;
template <int MF, class ARow>
DI void gemm_kloop(f32x4 (&acc)[MF][4], ARow arow, const bf16_t* __restrict__ Bt, int ldb, int K, char* smem) {
  const int tid = tidx(), wid = tid >> 6, lane = tid & 63, wr = wid >> 2, wc = wid & 3, fr = lane & 15, fq = lane >> 4;
  constexpr int AP = MF / 2;
  const bf16_t* ap[AP]; const bf16_t* bp[4];
  const int srow = tid >> 3, sch = tid & 7;
#pragma unroll
  for (int i = 0; i < AP; ++i) { const int r = srow + i * 64; ap[i] = arow(r) + ((sch ^ ((r >> 1) & 7)) << 3); }
#pragma unroll
  for (int i = 0; i < 4; ++i) { const int r = srow + i * 64; bp[i] = Bt + (size_t)r * ldb + ((sch ^ ((r >> 1) & 7)) << 3); }
  auto stage = [&](int buf, int kt) {
    char* SA = smem + buf * GSTAGE; char* SB = SA + 32768;
#pragma unroll
    for (int i = 0; i < AP; ++i)
      __builtin_amdgcn_global_load_lds((const void __attribute__((address_space(1)))*)(ap[i] + kt), (lds_ptr_t)(SA + tid * 16 + i * 8192), 16, 0, 0);
#pragma unroll
    for (int i = 0; i < 4; ++i)
      __builtin_amdgcn_global_load_lds((const void __attribute__((address_space(1)))*)(bp[i] + kt), (lds_ptr_t)(SB + tid * 16 + i * 8192), 16, 0, 0);
  };
  int aoff[MF], boff[4];
#pragma unroll
  for (int m = 0; m < MF; ++m) { const int r = wr * 16 * MF + m * 16 + fr; aoff[m] = r * 128 + ((fq ^ ((r >> 1) & 7)) << 4); }
#pragma unroll
  for (int n = 0; n < 4; ++n) { const int r = wc * 64 + n * 16 + fr; boff[n] = r * 128 + ((fq ^ ((r >> 1) & 7)) << 4); }
  stage(0, 0);
  asm volatile("s_waitcnt vmcnt(0)" ::: "memory");
  __syncthreads();
  int cur = 0;
#pragma unroll 1
  for (int kt = 0; kt < K; kt += 64) {
    if (kt + 64 < K) stage(cur ^ 1, kt + 64);
    const char* SA = smem + cur * GSTAGE; const char* SB = SA + 32768;
    constexpr int NST = 2 * (MF / 4);
    bf16x8 fa[2][4], fb[2][4];
    auto ldfrag = [&](int set, int st) {
      const int ks = st / (MF / 4), mh = st % (MF / 4);
#pragma unroll
      for (int n = 0; n < 4; ++n) fb[set][n] = *(const bf16x8*)(SB + (boff[n] ^ (ks << 6)));
#pragma unroll
      for (int m = 0; m < 4; ++m) fa[set][m] = *(const bf16x8*)(SA + (aoff[mh * 4 + m] ^ (ks << 6)));
    };
    ldfrag(0, 0);
    __builtin_amdgcn_sched_barrier(0);
#pragma unroll
    for (int st = 0; st < NST; ++st) {
      const int mh = st % (MF / 4);
#pragma unroll
      for (int n = 0; n < 4; ++n) acc[mh * 4][n] = __builtin_amdgcn_mfma_f32_16x16x32_bf16(fb[st & 1][n], fa[st & 1][0], acc[mh * 4][n], 0, 0, 0);
      __builtin_amdgcn_sched_barrier(0);
      if (st + 1 < NST) ldfrag((st + 1) & 1, st + 1);
      __builtin_amdgcn_sched_barrier(0);
#pragma unroll
      for (int m = 1; m < 4; ++m)
#pragma unroll
        for (int n = 0; n < 4; ++n) acc[mh * 4 + m][n] = __builtin_amdgcn_mfma_f32_16x16x32_bf16(fb[st & 1][n], fa[st & 1][m], acc[mh * 4 + m][n], 0, 0, 0);
      __builtin_amdgcn_sched_barrier(0);
    }
    asm volatile("s_waitcnt vmcnt(0)" ::: "memory");
    __syncthreads();
    cur ^= 1;
  }
}

DI int k8_lds_byte(int r, int c) { const int st = (r >> 4) * 2 + (c >> 5), rr = r & 15, cc = c & 31, ob = rr * 64 + cc * 2; return st * 1024 + (ob ^ (((ob >> 9) & 1) << 5)); }
DI void k8_stage_rc(int b, int& R, int& C) { const int st = b / 1024, sb = b % 1024, swz = sb ^ (((sb >> 9) & 1) << 5); R = (st >> 1) * 16 + swz / 64; C = (st & 1) * 32 + (swz % 64) / 2; }
template <class ARow>
DI void gemm_kloop8(f32x4 (&acc)[8][4], ARow arow, const bf16_t* __restrict__ Bt, int ldb, int K, char* smem) {
  constexpr int HTB = 16384;
  const int tid = tidx(), wid = tid >> 6, lane = tid & 63, wr = wid >> 2, wc = wid & 3, fr = lane & 15, fq = lane >> 4;
  int R0, C0; k8_stage_rc(tid * 16, R0, C0);
  unsigned aofs[2][2];
  if (!ARow::kDense) {
#pragma unroll
    for (int i = 0; i < 2; ++i)
#pragma unroll
      for (int hf = 0; hf < 2; ++hf) aofs[hf][i] = arow.off(i * 128 + hf * 64 + R0) + C0;
  } else { aofs[0][0] = arow.off(R0) + C0; }
  const unsigned astep = arow.off(64);
  const unsigned bofs0 = (unsigned)R0 * (unsigned)ldb + C0, bstep = 64u * (unsigned)ldb;
  const bf16_t* abase = arow.base;
  typedef const __attribute__((address_space(3))) char* ldsc_t;
  const int lpart = (fr * 64 + fq * 16) ^ ((fr >> 3) << 5);
  const ldsc_t la = (ldsc_t)smem + wr * 8192 + lpart;
  const ldsc_t lb = (ldsc_t)smem + wc * 4096 + lpart;
#define K8_SA(b, h) (((b) * 2 + (h)) * HTB)
#define K8_SB(b, h) ((4 + (b) * 2 + (h)) * HTB)
#define K8_STAGE_A(Pb, hf, kt) do { _Pragma("unroll") for (int _i = 0; _i < 2; ++_i) { \
    unsigned _sc = (unsigned)(kt) * 64u + (ARow::kDense ? ((hf) + 2 * _i) * astep : 0u); asm volatile("" : "+s"(_sc)); \
    __builtin_amdgcn_global_load_lds((const void __attribute__((address_space(1)))*)(abase + ((ARow::kDense ? aofs[0][0] : aofs[hf][_i]) + _sc)), (lds_ptr_t)(smem + (Pb) + tid * 16 + _i * 8192), 16, 0, 0); } } while (0)
#define K8_STAGE_B(Pb, hf, kt) do { _Pragma("unroll") for (int _i = 0; _i < 2; ++_i) { \
    unsigned _sc = (unsigned)(kt) * 64u + (2 * (hf) + _i) * bstep; asm volatile("" : "+s"(_sc)); \
    __builtin_amdgcn_global_load_lds((const void __attribute__((address_space(1)))*)(Bt + (bofs0 + _sc)), (lds_ptr_t)(smem + (Pb) + tid * 16 + _i * 8192), 16, 0, 0); } } while (0)
#define K8_LDA(dst, b, h) do { _Pragma("unroll") for (int m = 0; m < 4; ++m) { _Pragma("unroll") for (int k = 0; k < 2; ++k) \
    dst[m][k] = *(const __attribute__((address_space(3))) bf16x8*)(la + K8_SA(b, h) + (m * 2 + k) * 1024); } } while (0)
#define K8_LDB(dst, b, h) do { _Pragma("unroll") for (int n = 0; n < 2; ++n) { _Pragma("unroll") for (int k = 0; k < 2; ++k) \
    dst[n][k] = *(const __attribute__((address_space(3))) bf16x8*)(lb + K8_SB(b, h) + (n * 2 + k) * 1024); } } while (0)
#define K8_MMA(ai, bj, Af, Bf) do { __builtin_amdgcn_s_setprio(1); \
    _Pragma("unroll") for (int m = 0; m < 4; ++m) { _Pragma("unroll") for (int n = 0; n < 2; ++n) { _Pragma("unroll") for (int k = 0; k < 2; ++k) \
      acc[(ai) * 4 + m][(bj) * 2 + n] = __builtin_amdgcn_mfma_f32_16x16x32_bf16(Bf[n][k], Af[m][k], acc[(ai) * 4 + m][(bj) * 2 + n], 0, 0, 0); } } \
    __builtin_amdgcn_s_setprio(0); } while (0)
#define K8_WV(n) asm volatile("s_waitcnt vmcnt(" #n ")" ::: "memory")
#define K8_WL(n) asm volatile("s_waitcnt lgkmcnt(" #n ")" ::: "memory")
#define K8_BAR __builtin_amdgcn_s_barrier()
#define K8_SCHED __builtin_amdgcn_sched_barrier(0)
  bf16x8 At[4][2], B0[2][2], B1[2][2];
  const int nt = K / 64;
  K8_STAGE_B(K8_SB(0, 0), 0, 0); K8_STAGE_A(K8_SA(0, 0), 0, 0);
  K8_STAGE_B(K8_SB(0, 1), 1, 0); K8_STAGE_A(K8_SA(0, 1), 1, 0);
  if (wr == 1) K8_BAR;
  K8_WV(4); K8_BAR;
  K8_STAGE_B(K8_SB(1, 0), 0, 1); K8_STAGE_A(K8_SA(1, 0), 0, 1); K8_STAGE_B(K8_SB(1, 1), 1, 1);
  K8_WV(6); K8_BAR;
#pragma unroll 1
  for (int t = 0; t < nt - 2; t += 2) {
    K8_LDB(B0, 0, 0); K8_SCHED; K8_LDA(At, 0, 0); K8_STAGE_A(K8_SA(1, 1), 1, t + 1);
    K8_WL(8); K8_BAR; K8_WL(0); K8_MMA(0, 0, At, B0); K8_BAR; K8_SCHED;
    K8_LDB(B1, 0, 1); K8_STAGE_B(K8_SB(0, 0), 0, t + 2);
    K8_BAR; K8_WL(0); K8_MMA(0, 1, At, B1); K8_BAR;
    K8_LDA(At, 0, 1); K8_STAGE_A(K8_SA(0, 0), 0, t + 2);
    K8_BAR; K8_WL(0); K8_MMA(1, 0, At, B0); K8_BAR; K8_SCHED;
    K8_STAGE_B(K8_SB(0, 1), 1, t + 2);
    K8_WV(6); K8_BAR; K8_MMA(1, 1, At, B1); K8_BAR;
    K8_LDB(B0, 1, 0); K8_SCHED; K8_LDA(At, 1, 0); K8_STAGE_A(K8_SA(0, 1), 1, t + 2);
    K8_WL(8); K8_BAR; K8_WL(0); K8_MMA(0, 0, At, B0); K8_BAR; K8_SCHED;
    K8_LDB(B1, 1, 1); K8_STAGE_B(K8_SB(1, 0), 0, t + 3);
    K8_BAR; K8_WL(0); K8_MMA(0, 1, At, B1); K8_BAR;
    K8_LDA(At, 1, 1); K8_STAGE_A(K8_SA(1, 0), 0, t + 3);
    K8_BAR; K8_WL(0); K8_MMA(1, 0, At, B0); K8_BAR; K8_SCHED;
    K8_STAGE_B(K8_SB(1, 1), 1, t + 3);
    K8_WV(6); K8_BAR; K8_MMA(1, 1, At, B1); K8_BAR;
  }
  { K8_LDB(B0, 0, 0); K8_LDA(At, 0, 0); K8_STAGE_A(K8_SA(1, 1), 1, nt - 1);
    K8_BAR; K8_WL(0); K8_MMA(0, 0, At, B0); K8_BAR;
    K8_LDB(B1, 0, 1); K8_BAR; K8_WL(0); K8_MMA(0, 1, At, B1); K8_BAR;
    K8_LDA(At, 0, 1); K8_WV(4); K8_BAR; K8_WL(0); K8_MMA(1, 0, At, B0); K8_MMA(1, 1, At, B1); K8_BAR; }
  { K8_LDB(B0, 1, 0); K8_LDA(At, 1, 0); K8_WV(2); K8_BAR; K8_WL(0); K8_MMA(0, 0, At, B0); K8_BAR;
    K8_LDB(B1, 1, 1); K8_WV(0); K8_BAR; K8_WL(0); K8_MMA(0, 1, At, B1); K8_BAR;
    K8_LDA(At, 1, 1); K8_BAR; K8_WL(0); K8_MMA(1, 0, At, B0); K8_MMA(1, 1, At, B1); K8_BAR; }
  if (wr == 0) K8_BAR;
}
DI void k8_tile_end() { asm volatile("s_waitcnt vmcnt(0) lgkmcnt(0)" ::: "memory"); __syncthreads(); }

template <int MF>
DI void zero_acc(f32x4 (&acc)[MF][4]) {
#pragma unroll
  for (int m = 0; m < MF; ++m)
#pragma unroll
    for (int n = 0; n < 4; ++n) acc[m][n] = (f32x4){0.f, 0.f, 0.f, 0.f};
}
#define XCD_TILE_LOOP(n_mt, n_nt, mt, nt) \
  for (int xcd_ = bid & 7, cnt_ = ((n_nt) - xcd_ + 7) >> 3, q_ = bid >> 3, mt = 0, nt = 0; \
       q_ < (n_mt) * cnt_ && (mt = q_ / cnt_, nt = xcd_ + 8 * (q_ % cnt_), true); q_ += nblk >> 3)
#define TILE_LOOP(n_mt, n_nt, mt, nt) \
  for (int t_ = bid >> 3, mt = 0, nt = 0; t_ < (((n_mt) + 7) >> 3) * (n_nt) && (mt = (t_ / (n_nt)) * 8 + (bid & 7), nt = t_ % (n_nt), true); t_ += nblk >> 3) \
    if (mt < (n_mt))
struct RowsDense { const bf16_t* base; int ld; DI const bf16_t* operator()(int r) const { return base + (size_t)r * ld; } DI unsigned off(int r) const { return (unsigned)r * (unsigned)ld; } static constexpr bool kDense = true; };


template <int MF, class RowPtr>
DI void store_tile_bf16(const f32x4 (&v)[MF][4], char* smem, int wid, int lane, RowPtr dst) {
  char* W = smem + GSTAGE + wid * 8192;
  const int fr = lane & 15, fq = lane >> 4;
#pragma unroll
  for (int hm = 0; hm < MF / 4; ++hm) {
#pragma unroll
    for (int m = 0; m < 4; ++m)
#pragma unroll
      for (int n = 0; n < 4; ++n) {
        const int row = m * 16 + fr, c16 = 2 * n + (fq >> 1);
        u32x2 o; o[0] = pack2(v[hm * 4 + m][n][0], v[hm * 4 + m][n][1]); o[1] = pack2(v[hm * 4 + m][n][2], v[hm * 4 + m][n][3]);
        *(u32x2*)(W + row * 128 + ((c16 ^ (row & 7)) << 4) + (fq & 1) * 8) = o;
      }
    asm volatile("s_waitcnt lgkmcnt(0)" ::: "memory");
#pragma unroll
    for (int it = 0; it < 8; ++it) {
      const int row = it * 8 + (lane >> 3), c16 = lane & 7;
      const u32x4 d = *(const u32x4*)(W + row * 128 + ((c16 ^ (row & 7)) << 4));
      *(u32x4*)(dst(hm * 64 + row) + c16 * 8) = d;
    }
    asm volatile("s_waitcnt lgkmcnt(0)" ::: "memory");
  }
}

template <int MF, class RowPtr>
DI void store_tile_bf16_32(const f32x4 (&v)[MF][2], char* smem, int wid, int lane, RowPtr dst) {
  char* W = smem + GSTAGE + wid * 8192;
  const int fr = lane & 15, fq = lane >> 4;
#pragma unroll
  for (int hm = 0; hm < MF / 4; ++hm) {
#pragma unroll
    for (int m = 0; m < 4; ++m)
#pragma unroll
      for (int n = 0; n < 2; ++n) {
        const int row = m * 16 + fr, c16 = 2 * n + (fq >> 1);
        u32x2 o; o[0] = pack2(v[hm * 4 + m][n][0], v[hm * 4 + m][n][1]); o[1] = pack2(v[hm * 4 + m][n][2], v[hm * 4 + m][n][3]);
        *(u32x2*)(W + row * 64 + ((c16 ^ ((row >> 1) & 3)) << 4) + (fq & 1) * 8) = o;
      }
    asm volatile("s_waitcnt lgkmcnt(0)" ::: "memory");
#pragma unroll
    for (int it = 0; it < 4; ++it) {
      const int row = it * 16 + (lane >> 2), c16 = lane & 3;
      const u32x4 d = *(const u32x4*)(W + row * 64 + ((c16 ^ ((row >> 1) & 3)) << 4));
      *(u32x4*)(dst(hm * 64 + row) + c16 * 8) = d;
    }
    asm volatile("s_waitcnt lgkmcnt(0)" ::: "memory");
  }
}

template <int MF, class RowPtr>
DI void store_tile_u8(const f32x4 (&v)[MF][4], char* smem, int wid, int lane, RowPtr dst) {
  char* W = smem + GSTAGE + wid * 8192;
  const int fr = lane & 15, fq = lane >> 4;
#pragma unroll
  for (int hm = 0; hm < MF / 4; ++hm) {
#pragma unroll
    for (int m = 0; m < 4; ++m)
#pragma unroll
      for (int n = 0; n < 4; ++n) {
        const int row = m * 16 + fr;
        const f32x4 q = v[hm * 4 + m][n] * 255.f + 0.5f;
        const unsigned o = (unsigned)q[0] | ((unsigned)q[1] << 8) | ((unsigned)q[2] << 16) | ((unsigned)q[3] << 24);
        *(unsigned*)(W + row * 64 + ((n ^ ((row >> 1) & 3)) << 4) + fq * 4) = o;
      }
    asm volatile("s_waitcnt lgkmcnt(0)" ::: "memory");
#pragma unroll
    for (int it = 0; it < 4; ++it) {
      const int row = it * 16 + (lane >> 2), c16 = lane & 3;
      const u32x4 d = *(const u32x4*)(W + row * 64 + ((c16 ^ ((row >> 1) & 3)) << 4));
      *(u32x4*)(dst(hm * 64 + row) + c16 * 16) = d;
    }
    asm volatile("s_waitcnt lgkmcnt(0)" ::: "memory");
  }
}

template <int MF>
DI void store_tile_vt(const f32x4 (&v)[MF][4], char* smem, int wid, int lane, bf16_t* vt0) {
  char* W = smem + GSTAGE + wid * 8192;
  const int fr = lane & 15, fq = lane >> 4;
#pragma unroll
  for (int hm = 0; hm < MF / 4; ++hm) {
#pragma unroll
    for (int m = 0; m < 4; ++m) {
      const int trow = m * 16 + fr, pos = (trow & ~31) + perm32(trow & 31);
#pragma unroll
      for (int j = 0; j < 4; ++j) {
        const int dl = fq * 4 + j;
        __attribute__((address_space(3))) bf16_t* wp = (__attribute__((address_space(3))) bf16_t*)(W + dl * 128 + (((pos >> 3) ^ (dl & 7)) << 4) + (pos & 7) * 2);
#pragma unroll
        for (int n = 0; n < 4; ++n) wp[n * 1024] = (bf16_t)(pack2(v[hm * 4 + m][n][j], 0.f) & 0xffffu);
      }
    }
    asm volatile("s_waitcnt lgkmcnt(0)" ::: "memory");
#pragma unroll 1
    for (int it = 0; it < 8; ++it) {
      const int dim = it * 8 + (lane >> 3), c16 = lane & 7;
      const u32x4 d = *(const u32x4*)(W + dim * 128 + ((c16 ^ (dim & 7)) << 4));
      *(u32x4*)(vt0 + (size_t)dim * 4096 + hm * 64 + c16 * 8) = d;
    }
    asm volatile("s_waitcnt lgkmcnt(0)" ::: "memory");
  }
}

DI void phase_inproj(const Params& p, int layer, int bid, int nblk, char* smem) {
  char* wsq = opqp(p.ws);
  const bf16_t* hb = (const bf16_t*)(wsq + OFF_HB);
  const bf16_t* wt = (const bf16_t*)(wsq + OFF_WIN) + (size_t)layer * 6912 * 1024;
  constexpr int NTN = PW / 256;
  TILE_LOOP(NT / 256, NTN, mt, nt) {
    f32x4 acc[8][4]; zero_acc(acc);
    gemm_kloop8(acc, RowsDense{hb + (size_t)mt * 256 * DM, DM}, wt + (size_t)nt * 256 * DM, DM, DM, smem);
    const int t2 = tidx(), lane = t2 & 63, wid = t2 >> 6, wr = wid >> 2, wc = wid & 3, fr = lane & 15, fq = lane >> 4;
    char* ws2 = opqp(wsq);
    bf16_t* P = (bf16_t*)(ws2 + OFF_P); bf16_t* VT = (bf16_t*)(ws2 + OFF_VT);
    float* LOGF = (float*)(ws2 + OFF_LOGF); float* IW = (float*)(ws2 + OFF_IW);
    const int unit = nt * 4 + wc;
    int gsel = -1; float scale = 1.f; int vh = -1;
    if (unit < 4) { gsel = 0; scale = QS_SWA; } else if (unit < 6) gsel = 1;
    else if (unit < 8) vh = unit - 6;
    else if (unit < 12) { gsel = 2; scale = QS_FOX; } else if (unit < 16) gsel = 3;
    else if (unit < 20) vh = 2 + unit - 16;
    else if (unit < 24) scale = QS_SB;
    else if (unit >= 28 && unit < 32) vh = 6 + unit - 28;
    else if (unit >= 32 && unit < 36) { gsel = 4; scale = QS_DSA; } else if (unit == 36) gsel = 5;
    else if (unit == 37) vh = 10;
    else if (unit >= 38 && unit < 42) scale = 0.125f;
    const float* gain = p.qk_gain + (size_t)layer * 384 + (gsel < 0 ? 0 : gsel) * 64;
    if (unit == U_SM) {
#pragma unroll
      for (int m = 0; m < 8; ++m) {
        const int tok = mt * 256 + wr * 128 + m * 16 + fr;
        if (fq == 0) {
          f32x4 v = acc[m][0]; f32x4 o;
#pragma unroll
          for (int j = 0; j < 4; ++j) o[j] = log_sigmoid_f(v[j] + p.forget_bias[layer * 4 + j]);
          *(f32x4*)(LOGF + (size_t)tok * 4) = o;
        } else if (fq == 1) {
          f32x4 v = acc[m][0];
          *(f32x4*)(IW + (size_t)tok * 4) = v * 0.5f;
        }
      }
    } else {
#pragma unroll
      for (int m = 0; m < 8; ++m) {
        float r = 1.f;
        if (gsel >= 0) {
          float ss = 0.f;
#pragma unroll
          for (int n = 0; n < 4; ++n)
#pragma unroll
            for (int j = 0; j < 4; ++j) ss += acc[m][n][j] * acc[m][n][j];
          ss += __shfl_xor(ss, 16); ss += __shfl_xor(ss, 32);
          r = rsqrtf(ss * (1.f / 64.f) + 1e-6f);
        }
#pragma unroll
        for (int n = 0; n < 4; ++n) {
          f32x4 v = acc[m][n];
          if (gsel >= 0) { f32x4 gg = *(const f32x4*)(gain + n * 16 + fq * 4); v = v * r * gg; }
          acc[m][n] = v * scale;
        }
      }
      const int ln = lane, tok0 = mt * 256 + wr * 128;
      if (vh >= 0) {
        store_tile_vt<8>(acc, smem, wid, ln, VT + (((size_t)(tok0 >> 12) * 11 + vh) * 64) * 4096 + (tok0 & 4095));
      } else {
        bf16_t* pb = P + (size_t)tok0 * PW + unit * 64;
        store_tile_bf16<8>(acc, smem, wid, ln, [&](int row) { return pb + (size_t)row * PW; });
      }
    }
    k8_tile_end();
  }
}

DI void phase_cumsum(const Params& p, int bid, int nblk) {
  char* wsq = opqp(p.ws);
  const float* LOGF = (const float*)(wsq + OFF_LOGF); float* CT = (float*)(wsq + OFF_CT);
  const int lane = tidx() & 63, wid = tidx() >> 6;
  for (int seq = bid * NWV + wid; seq < 32; seq += nblk * NWV) {
    const int b = seq >> 2, h = seq & 3;
    float tot = 0.f;
    for (int i = 0; i < 64; ++i) tot += LOGF[((size_t)b * 4096 + lane * 64 + i) * 4 + h];
    float incl = tot;
    for (int o = 1; o < 64; o <<= 1) { float t = __shfl_up(incl, o); if (lane >= o) incl += t; }
    float run = incl - tot;
    for (int i = 0; i < 64; ++i) { run += LOGF[((size_t)b * 4096 + lane * 64 + i) * 4 + h]; const int sidx = lane * 64 + i; CT[((size_t)b * 4 + h) * 4096 + (sidx & ~31) + perm32(sidx & 31)] = run * LOG2E; }
  }
}

typedef float f32x16 __attribute__((ext_vector_type(16)));
#define MFMA32(a, b, c) __builtin_amdgcn_mfma_f32_32x32x16_bf16((a), (b), (c), 0, 0, 0)
#define CROW(i, h) (((i) & 3) + 8 * ((i) >> 2) + 4 * (h))
DI size_t sc_row_off(int b, int t) { const int i = t >> 5; return (size_t)b * SC_PER_B + 1024UL * ((size_t)i * (i + 1) / 2) + (size_t)(t & 31) * (size_t)((i + 1) * 32); }
DI f32x16 zero16() { f32x16 z;
#pragma unroll
  for (int i = 0; i < 16; ++i) z[i] = 0.f; return z; }
DI bf16x8 pack_step(const f32x16& x, int s) {
  u32x4 v; v[0] = pack2(x[8 * s], x[8 * s + 1]); v[1] = pack2(x[8 * s + 2], x[8 * s + 3]); v[2] = pack2(x[8 * s + 4], x[8 * s + 5]); v[3] = pack2(x[8 * s + 6], x[8 * s + 7]);
  return __builtin_bit_cast(bf16x8, v);
}
DI void load_qf(bf16x8 (&qf)[4], const bf16_t* qp) {
#pragma unroll
  for (int ks = 0; ks < 4; ++ks) qf[ks] = *(const bf16x8*)(qp + 16 * ks);
}
DI void store_ot(bf16_t* op, const f32x16 (&o)[2], float scale, int h) {
#pragma unroll
  for (int db = 0; db < 2; ++db)
#pragma unroll
    for (int g = 0; g < 4; ++g) {
      u32x2 w; w[0] = pack2(o[db][4 * g] * scale, o[db][4 * g + 1] * scale); w[1] = pack2(o[db][4 * g + 2] * scale, o[db][4 * g + 3] * scale);
      *(u32x2*)(op + 32 * db + 8 * g + 4 * h) = w;
    }
}
DI void glds16(const void* g, void* l) { __builtin_amdgcn_global_load_lds((const void __attribute__((address_space(1)))*)g, (lds_ptr_t)l, 16, 0, 0); }
DI bf16x8 lds_frag(const char* base, int row, int chunk) { return *(const bf16x8*)(base + row * 128 + ((chunk ^ ((row >> 1) & 7)) << 4)); }

DI f32x16 qk_tile(const bf16_t* kp, const bf16x8 (&qf)[4]) {
  f32x16 acc = zero16();
#pragma unroll
  for (int ks = 0; ks < 4; ++ks) { bf16x8 kf = *(const bf16x8*)(kp + 16 * ks); acc = MFMA32(kf, qf[ks], acc); }
  return acc;
}
DI void pv_tile(f32x16 (&o)[2], const bf16_t* vp, const f32x16& pacc) {
#pragma unroll
  for (int s = 0; s < 2; ++s) {
    const bf16x8 pb = pack_step(pacc, s);
#pragma unroll
    for (int db = 0; db < 2; ++db) { const bf16x8 vf = *(const bf16x8*)(vp + (size_t)db * 32 * 4096 + 8 * s); o[db] = MFMA32(vf, pb, o[db]); }
  }
}
DI void fast_swa(const Params& p, int layer, int b, int hq, int qt, int lane, const float* tb  ) {
  const bf16_t* P = (const bf16_t*)(p.ws + OFF_P); bf16_t* O = (bf16_t*)(p.ws + OFF_O);
  const int kv = hq >> 1;
  const bf16_t* vt = (const bf16_t*)(p.ws + OFF_VT) + ((size_t)b * 11 + kv) * 64 * 4096;
  const int r = lane & 31, h = lane >> 5, q0 = qt * 32;
  bf16x8 qf[4]; load_qf(qf, P + (size_t)(b * 4096 + q0 + r) * PW + (U_AQ + hq) * 64 + 8 * h);
  f32x16 o[2]; o[0] = zero16(); o[1] = zero16();
  float m = p.attn_sinks[layer * 4 + hq] * LOG2E, l = (h == 0) ? 1.f : 0.f;
  const bf16_t* kbase = P + (size_t)(b * 4096 + r) * PW + (U_AK + kv) * 64 + 8 * h;
  const bf16_t* vbase = vt + (size_t)r * 4096 + 16 * h;
  for (int kb = (qt >= 4 ? qt - 4 : 0); kb <= qt; ++kb) {
    const int key0 = kb * 32;
    f32x16 s = qk_tile(kbase + (size_t)key0 * PW, qf);
#pragma unroll
    for (int i = 0; i < 16; ++i) {
      const int dist = q0 + r - key0 - CROW(i, h);
      const bool ok = dist >= 0 && dist < 128;
      s[i] = ok ? s[i] + tb[hq * 128 + (dist & 127)] : -INFINITY;
    }
    float ml = s[0];
#pragma unroll
    for (int i = 1; i < 16; ++i) ml = fmaxf(ml, s[i]);
    ml = fmaxf(ml, __shfl_xor(ml, 32));
    const float mn = fmaxf(m, ml);
    const float alpha = __builtin_amdgcn_exp2f(m - mn);
    float ps = 0.f;
#pragma unroll
    for (int i = 0; i < 16; ++i) { s[i] = __builtin_amdgcn_exp2f(s[i] - mn); ps += s[i]; }
    l = l * alpha + ps; m = mn;
#pragma unroll
    for (int i = 0; i < 16; ++i) { o[0][i] *= alpha; o[1][i] *= alpha; }
    pv_tile(o, vbase + key0, s);
  }
  l += __shfl_xor(l, 32);
  store_ot(O + (size_t)(b * 4096 + q0 + r) * 1024 + hq * 64, o, 1.f / l, h);
}

constexpr int ABUF = 16384 + 2048, RING = 4;
struct KVStream {
  const bf16_t* kg; const bf16_t* vg; const float* cg; int tid;
  DI void stage(char* smem, int buf, int j) const {
    char* B = smem + buf * ABUF;
    glds16(kg + (size_t)64 * j * PW, B + tid * 16);
    glds16(vg + 64 * j, B + 8192 + tid * 16);
    if (cg) { if ((tid & 63) < 2) glds16(cg + 64 * j, B + 16384 + ((tid >> 6) * 2 + (tid & 63)) * 16); }
  }
};
DI KVStream make_stream(const bf16_t* krow0  , const bf16_t* vt  , const float* c  , int tid) {
  const int srow = tid >> 3, sch = tid & 7, fs = (srow >> 1) & 7;
  KVStream st; st.tid = tid;
  st.kg = krow0 + (size_t)srow * PW + ((sch ^ fs) << 3);
  st.vg = vt + (size_t)srow * 4096 + ((sch ^ fs) << 3);
  st.cg = c ? c + 4 * ((tid >> 6) * 2 + (tid & 63)) : nullptr;
  return st;
}
template <int NL> DI void ring_wait_barrier(int ahead) {
  if (NL == 3) { if (ahead >= 2) asm volatile("s_waitcnt vmcnt(6)" ::: "memory"); else if (ahead == 1) asm volatile("s_waitcnt vmcnt(3)" ::: "memory"); else asm volatile("s_waitcnt vmcnt(0)" ::: "memory"); }
  else { if (ahead >= 2) asm volatile("s_waitcnt vmcnt(4)" ::: "memory"); else if (ahead == 1) asm volatile("s_waitcnt vmcnt(2)" ::: "memory"); else asm volatile("s_waitcnt vmcnt(0)" ::: "memory"); }
  asm volatile("s_waitcnt lgkmcnt(0)" ::: "memory");
  __builtin_amdgcn_s_barrier();
  asm volatile("" ::: "memory");
}
DI f32x16 qk_lds(const char* KB, int u, int r, int h, const bf16x8 (&qf)[4]) {
  f32x16 acc = zero16();
#pragma unroll
  for (int ks = 0; ks < 4; ++ks) acc = MFMA32(lds_frag(KB, 32 * u + r, 2 * ks + h), qf[ks], acc);
  return acc;
}
DI void pv_lds(f32x16 (&o)[2], const char* VB, int u, int r, int h, const f32x16& pacc) {
#pragma unroll
  for (int s = 0; s < 2; ++s) {
    const bf16x8 pb = pack_step(pacc, s);
#pragma unroll
    for (int db = 0; db < 2; ++db) o[db] = MFMA32(lds_frag(VB, 32 * db + r, 4 * u + 2 * h + s), pb, o[db]);
  }
}
DI float max3f(float a, float b, float c) { float r; asm("v_max3_f32 %0, %1, %2, %3" : "=v"(r) : "v"(a), "v"(b), "v"(c)); return r; }
DI void pk_sub_scalar(f32x16& s, float m) {
  const f32x2 mm = {m, m};
#pragma unroll
  for (int i = 0; i < 8; ++i) {
    f32x2 t = {s[2 * i], s[2 * i + 1]}, r;
    asm("v_pk_add_f32 %0, %1, %2 neg_lo:[0,1] neg_hi:[0,1]" : "=v"(r) : "v"(t), "v"(mm));
    s[2 * i] = r[0]; s[2 * i + 1] = r[1];
  }
}
DI float pk_sum(const f32x16& s) {
  f32x2 a = {s[0], s[1]}, b = {s[2], s[3]};
#pragma unroll
  for (int i = 2; i < 8; i += 2) { a = a + (f32x2){s[2 * i], s[2 * i + 1]}; b = b + (f32x2){s[2 * i + 2], s[2 * i + 3]}; }
  a = a + b; return a[0] + a[1];
}
DI void online_softmax(f32x16& s, float& m, float& l, f32x16 (&o)[2]) {
  float ml = max3f(s[0], s[1], s[2]);
#pragma unroll
  for (int i = 3; i < 15; i += 2) ml = max3f(ml, s[i], s[i + 1]);
  ml = max3f(ml, s[15], __shfl_xor(max3f(ml, s[15], s[15]), 32));
  if (__builtin_expect(__ballot(ml > m + 8.f) != 0ULL, 0)) {
    const float mn = fmaxf(m, ml);
    const float ms = (mn == -INFINITY) ? 0.f : mn;
    const float alpha = __builtin_amdgcn_exp2f(m - ms);
    l *= alpha; m = mn;
    const f32x2 aa = {alpha, alpha};
#pragma unroll
    for (int i = 0; i < 8; ++i) {
      f32x2 t0 = {o[0][2 * i], o[0][2 * i + 1]}, t1 = {o[1][2 * i], o[1][2 * i + 1]};
      t0 = t0 * aa; t1 = t1 * aa; o[0][2 * i] = t0[0]; o[0][2 * i + 1] = t0[1]; o[1][2 * i] = t1[0]; o[1][2 * i + 1] = t1[1];
    }
  }
  pk_sub_scalar(s, (m == -INFINITY) ? 0.f : m);
#pragma unroll
  for (int i = 0; i < 16; ++i) s[i] = __builtin_amdgcn_exp2f(s[i]);
  l += pk_sum(s);
}


DI void qk_lds2(f32x16& s0, f32x16& s1, const char* KB, int r, int h, const bf16x8 (&qf)[4]) {
  bf16x8 k0[4], k1[4];
#pragma unroll
  for (int ks = 0; ks < 4; ++ks) { k0[ks] = lds_frag(KB, r, 2 * ks + h); k1[ks] = lds_frag(KB, 32 + r, 2 * ks + h); }
  s0 = zero16(); s1 = zero16();
#pragma unroll
  for (int ks = 0; ks < 4; ++ks) { s0 = MFMA32(k0[ks], qf[ks], s0); s1 = MFMA32(k1[ks], qf[ks], s1); }
}
DI void ld_vfrags(bf16x8 (&vf)[2][2][2], const char* VB, int r, int h) {
#pragma unroll
  for (int u = 0; u < 2; ++u)
#pragma unroll
    for (int db = 0; db < 2; ++db)
#pragma unroll
      for (int sx = 0; sx < 2; ++sx) vf[u][db][sx] = lds_frag(VB, 32 * db + r, 4 * u + 2 * h + sx);
}
DI void pv2(f32x16 (&o)[2], const bf16x8 (&vf)[2][2][2], const f32x16& p0, const f32x16& p1) {
#pragma unroll
  for (int sx = 0; sx < 2; ++sx) {
    const bf16x8 pb0 = pack_step(p0, sx), pb1 = pack_step(p1, sx);
#pragma unroll
    for (int db = 0; db < 2; ++db) { o[db] = MFMA32(vf[0][db][sx], pb0, o[db]); o[db] = MFMA32(vf[1][db][sx], pb1, o[db]); }
  }
}
DI void online_softmax2(f32x16& s0, f32x16& s1, float& m, float& l, f32x16 (&o)[2]) {
  float ml = max3f(s0[0], s0[1], s1[0]);
#pragma unroll
  for (int i = 1; i < 15; i += 2) { ml = max3f(ml, s0[i + 1], s0[i + 2 > 15 ? 15 : i + 2]); ml = max3f(ml, s1[i], s1[i + 1]); }
  ml = max3f(ml, s1[15], s0[15]);
  ml = fmaxf(ml, __shfl_xor(ml, 32));
  if (__builtin_expect(__ballot(ml > m + 8.f) != 0ULL, 0)) {
    const float mn = fmaxf(m, ml);
    const float ms = (mn == -INFINITY) ? 0.f : mn;
    const float alpha = __builtin_amdgcn_exp2f(m - ms);
    l *= alpha; m = mn;
    const f32x2 aa = {alpha, alpha};
#pragma unroll
    for (int i = 0; i < 8; ++i) {
      f32x2 t0 = {o[0][2 * i], o[0][2 * i + 1]}, t1 = {o[1][2 * i], o[1][2 * i + 1]};
      t0 = t0 * aa; t1 = t1 * aa; o[0][2 * i] = t0[0]; o[0][2 * i + 1] = t0[1]; o[1][2 * i] = t1[0]; o[1][2 * i + 1] = t1[1];
    }
  }
  const float mr = (m == -INFINITY) ? 0.f : m;
  pk_sub_scalar(s0, mr); pk_sub_scalar(s1, mr);
#pragma unroll
  for (int i = 0; i < 16; ++i) { s0[i] = __builtin_amdgcn_exp2f(s0[i]); s1[i] = __builtin_amdgcn_exp2f(s1[i]); }
  l += pk_sum(s0) + pk_sum(s1);
}

DI void fox_block(const Params& p, int b, int hd, int qb, char* smem) {
  char* wsq = opqp(p.ws);
  const bf16_t* P = (const bf16_t*)(wsq + OFF_P); bf16_t* O = (bf16_t*)(wsq + OFF_O);
  const int tid = tidx(), lane = tid & 63, wid = __builtin_amdgcn_readfirstlane(tid >> 6), r = lane & 31, h = lane >> 5;
  const int q0 = qb * 256 + 32 * wid, ntile = qb * 4 + 4, jmax = (q0 + 31) >> 6;
  const KVStream st = make_stream(P + (size_t)b * 4096 * PW + (U_FK + hd) * 64, (const bf16_t*)(wsq + OFF_VT) + ((size_t)b * 11 + 2 + hd) * 64 * 4096,
                                  (const float*)(wsq + OFF_CT) + ((size_t)b * 4 + hd) * 4096, tid);
  bf16x8 qf[4]; load_qf(qf, P + (size_t)(b * 4096 + q0 + r) * PW + (U_FQ + hd) * 64 + 8 * h);
  asm volatile("" :: "v"(qf[0]), "v"(qf[1]), "v"(qf[2]), "v"(qf[3]));
  f32x16 o[2]; o[0] = zero16(); o[1] = zero16();
  float m = -INFINITY, l = 0.f;
  __syncthreads();
#pragma unroll 1
  for (int j = 0; j < RING - 1 && j < ntile; ++j) st.stage(smem, j, j);
  ring_wait_barrier<3>((ntile - 1 < RING - 2 ? ntile - 1 : RING - 2));
#pragma unroll 1
  for (int j = 0; j < ntile; ++j) {
    if (j + RING - 1 < ntile) st.stage(smem, (j + RING - 1) & (RING - 1), j + RING - 1);
    if (j <= jmax) {
      const char* B = smem + (j & (RING - 1)) * ABUF;
      f32x16 s0, s1;
      qk_lds2(s0, s1, B, r, h, qf);
      bf16x8 vf[2][2][2]; ld_vfrags(vf, B + 8192, r, h);
#pragma unroll
      for (int g = 0; g < 4; ++g) {
        const f32x4 ca = *(const f32x4*)(B + 16384 + (16 * h + 4 * g) * 4), cb = *(const f32x4*)(B + 16384 + (32 + 16 * h + 4 * g) * 4);
        f32x2 t0 = {s0[4 * g], s0[4 * g + 1]}, t1 = {s0[4 * g + 2], s0[4 * g + 3]}, t2 = {s1[4 * g], s1[4 * g + 1]}, t3 = {s1[4 * g + 2], s1[4 * g + 3]};
        t0 = t0 - (f32x2){ca[0], ca[1]}; t1 = t1 - (f32x2){ca[2], ca[3]}; t2 = t2 - (f32x2){cb[0], cb[1]}; t3 = t3 - (f32x2){cb[2], cb[3]};
        s0[4 * g] = t0[0]; s0[4 * g + 1] = t0[1]; s0[4 * g + 2] = t1[0]; s0[4 * g + 3] = t1[1];
        s1[4 * g] = t2[0]; s1[4 * g + 1] = t2[1]; s1[4 * g + 2] = t3[0]; s1[4 * g + 3] = t3[1];
      }
      if (__builtin_expect(64 * j + 63 > q0, 0)) {
#pragma unroll
        for (int i = 0; i < 16; ++i) {
          if (64 * j + CROW(i, h) > q0 + r) s0[i] = -INFINITY;
          if (64 * j + 32 + CROW(i, h) > q0 + r) s1[i] = -INFINITY;
        }
        asm volatile("" ::: "memory");
      }
      online_softmax2(s0, s1, m, l, o);
      pv2(o, vf, s0, s1);
    }
    if (j + 1 < ntile) ring_wait_barrier<3>((ntile - 1 < j + RING - 1 ? ntile - 1 : j + RING - 1) - (j + 1));
  }
  l += __shfl_xor(l, 32);
  store_ot(O + (size_t)(b * 4096 + q0 + r) * 1024 + 256 + hd * 64, o, 1.f / l, h);
}

DI void sb_block(const Params& p, int b, int hd, int qb, char* smem) {
  char* wsq = opqp(p.ws);
  const bf16_t* P = (const bf16_t*)(wsq + OFF_P); bf16_t* O = (bf16_t*)(wsq + OFF_O);
  const int tid = tidx(), lane = tid & 63, wid = __builtin_amdgcn_readfirstlane(tid >> 6), r = lane & 31, h = lane >> 5;
  const int q0 = qb * 256 + 32 * wid, ntile = qb * 4 + 4, jmax = (q0 + 31) >> 6;
  const KVStream st = make_stream(P + (size_t)b * 4096 * PW + (U_SK + hd) * 64, (const bf16_t*)(wsq + OFF_VT) + ((size_t)b * 11 + 6 + hd) * 64 * 4096, nullptr, tid);
  bf16x8 qf[4]; load_qf(qf, P + (size_t)(b * 4096 + q0 + r) * PW + (U_SQ + hd) * 64 + 8 * h);
  asm volatile("" :: "v"(qf[0]), "v"(qf[1]), "v"(qf[2]), "v"(qf[3]));
  f32x16 o[2]; o[0] = zero16(); o[1] = zero16();
  float R = 0.f;
  volatile int* flg = (volatile int*)(smem + RING * ABUF);
  __syncthreads();
#pragma unroll 1
  for (int it = 0; it < RING - 1 && it < ntile; ++it) st.stage(smem, it, ntile - 1 - it);
  ring_wait_barrier<2>((ntile - 1 < RING - 2 ? ntile - 1 : RING - 2));
#pragma unroll 1
  for (int it = 0; it < ntile; ++it) {
    const int j = ntile - 1 - it;
    if (it + RING - 1 < ntile) st.stage(smem, (it + RING - 1) & (RING - 1), j - (RING - 1));
    const bool wdone = __ballot(R >= -160.f) == 0ULL;
    if (j <= jmax && !wdone) {
      const char* B = smem + (it & (RING - 1)) * ABUF;
#pragma unroll
      for (int uu = 0; uu < 2; ++uu) {
        const int u = 1 - uu, key0 = 64 * j + 32 * u;
        if (key0 <= q0) {
          const bool diag = key0 == q0;
          f32x16 z = qk_lds(B, u, r, h, qf);
          f32x16 lk;
#pragma unroll
          for (int i = 0; i < 16; ++i) {
            const float t = __builtin_amdgcn_exp2f(-fabsf(z[i]));
            lk[i] = -(fmaxf(z[i], 0.f) + __builtin_amdgcn_logf(1.f + t));
          }
          if (diag) {
#pragma unroll
            for (int i = 0; i < 16; ++i) if (CROW(i, h) >= r) lk[i] = 0.f;
          }
          float gs[4], ps[4];
#pragma unroll
          for (int g = 0; g < 4; ++g) { gs[g] = (lk[4 * g] + lk[4 * g + 1]) + (lk[4 * g + 2] + lk[4 * g + 3]); ps[g] = __shfl_xor(gs[g], 32); }
          float run = R;
          f32x16 a;
#pragma unroll
          for (int g = 3; g >= 0; --g) {
            float later = run + (h == 0 ? ps[g] : 0.f);
#pragma unroll
            for (int jj = 3; jj >= 0; --jj) { const int i = 4 * g + jj; a[i] = __builtin_amdgcn_exp2f(z[i] + lk[i] + later); later += lk[i]; }
            run += gs[g] + ps[g];
          }
          R = run;
          if (diag) {
#pragma unroll
            for (int i = 0; i < 16; ++i) if (CROW(i, h) >= r) a[i] = 0.f;
          }
          pv_lds(o, B + 8192, u, r, h, a);
        }
      }
    }
    if (it + 1 < ntile) {
      if (lane == 0) flg[(it & 1) * 8 + wid] = (__ballot(R >= -160.f) == 0ULL) ? 1 : 0;
      ring_wait_barrier<2>((ntile - 1 < it + RING - 1 ? ntile - 1 : it + RING - 1) - (it + 1));
      int alld = 1;
#pragma unroll
      for (int w = 0; w < 8; ++w) alld &= flg[(it & 1) * 8 + w];
      if (alld) { asm volatile("s_waitcnt vmcnt(0)" ::: "memory"); break; }
    }
  }
  store_ot(O + (size_t)(b * 4096 + q0 + r) * 1024 + 512 + hd * 64, o, 1.f, h);
}


DI void swa_block(const Params& p, int layer, int b, int kv, int qb, char* smem, const float* tb  ) {
  char* wsq = opqp(p.ws);
  const bf16_t* P = (const bf16_t*)(wsq + OFF_P); bf16_t* O = (bf16_t*)(wsq + OFF_O);
  const int tid = tidx(), lane = tid & 63, wid = __builtin_amdgcn_readfirstlane(tid >> 6), r = lane & 31, h = lane >> 5;
  const int q0 = qb * 256 + 32 * wid, jlo = qb > 0 ? qb * 4 - 2 : 0, ntile = qb * 4 + 4 - jlo;
  const KVStream st = make_stream(P + (size_t)b * 4096 * PW + (U_AK + kv) * 64, (const bf16_t*)(wsq + OFF_VT) + ((size_t)b * 11 + kv) * 64 * 4096, nullptr, tid);
  bf16x8 qf[2][4];
#pragma unroll
  for (int g = 0; g < 2; ++g) load_qf(qf[g], P + (size_t)(b * 4096 + q0 + r) * PW + (U_AQ + 2 * kv + g) * 64 + 8 * h);
  asm volatile("" :: "v"(qf[0][0]), "v"(qf[0][1]), "v"(qf[0][2]), "v"(qf[0][3]), "v"(qf[1][0]), "v"(qf[1][1]), "v"(qf[1][2]), "v"(qf[1][3]));
  f32x16 o[2][2];
  float m[2], l[2];
#pragma unroll
  for (int g = 0; g < 2; ++g) { o[g][0] = zero16(); o[g][1] = zero16(); m[g] = p.attn_sinks[layer * 4 + 2 * kv + g] * LOG2E; l[g] = (h == 0) ? 1.f : 0.f; }
  __syncthreads();
#pragma unroll 1
  for (int it = 0; it < RING - 1 && it < ntile; ++it) st.stage(smem, it, jlo + it);
  ring_wait_barrier<2>((ntile - 1 < RING - 2 ? ntile - 1 : RING - 2));
#pragma unroll 1
  for (int it = 0; it < ntile; ++it) {
    const int j = jlo + it;
    if (it + RING - 1 < ntile) st.stage(smem, (it + RING - 1) & (RING - 1), j + RING - 1);
    const char* B = smem + (it & (RING - 1)) * ABUF;
#pragma unroll
    for (int u = 0; u < 2; ++u) {
      const int key0 = 64 * j + 32 * u;
      if (key0 <= q0 && key0 + 128 >= q0) {
        const bool edge = (key0 == q0) || (key0 + 128 == q0);
#pragma unroll
        for (int g = 0; g < 2; ++g) {
          f32x16 s = qk_lds(B, u, r, h, qf[g]);
          const float* tbh = tb + (2 * kv + g) * 128;
#pragma unroll
          for (int i = 0; i < 16; ++i) {
            const int dist = q0 + r - key0 - CROW(i, h);
            s[i] += tbh[dist & 127];
            if (edge && (dist < 0 || dist >= 128)) s[i] = -INFINITY;
          }
          online_softmax(s, m[g], l[g], o[g]);
          pv_lds(o[g], B + 8192, u, r, h, s);
        }
      }
    }
    if (it + 1 < ntile) ring_wait_barrier<2>((ntile - 1 < it + RING - 1 ? ntile - 1 : it + RING - 1) - (it + 1));
  }
#pragma unroll
  for (int g = 0; g < 2; ++g) {
    const float lt = l[g] + __shfl_xor(l[g], 32);
    store_ot(O + (size_t)(b * 4096 + q0 + r) * 1024 + (2 * kv + g) * 64, o[g], 1.f / lt, h);
  }
}

DI void dsa_block(const Params& p, int b, int qb, char* smem, const float* tb  ) {
  char* wsq = opqp(p.ws);
  const bf16_t* P = (const bf16_t*)(wsq + OFF_P); bf16_t* O = (bf16_t*)(wsq + OFF_O);
  const unsigned* MW = (const unsigned*)(wsq + OFF_MASK);
  const int tid = tidx(), lane = tid & 63, wid = __builtin_amdgcn_readfirstlane(tid >> 6), r = lane & 31, h = lane >> 5;
  const int hd = wid & 3, q0 = qb * 64 + 32 * (wid >> 2), ntile = qb + 1;
  const KVStream st = make_stream(P + (size_t)b * 4096 * PW + U_DK * 64, (const bf16_t*)(wsq + OFF_VT) + ((size_t)b * 11 + 10) * 64 * 4096, nullptr, tid);
  bf16x8 qf[4]; load_qf(qf, P + (size_t)(b * 4096 + q0 + r) * PW + (U_DQ + hd) * 64 + 8 * h);
  asm volatile("" :: "v"(qf[0]), "v"(qf[1]), "v"(qf[2]), "v"(qf[3]));
  f32x16 o[2]; o[0] = zero16(); o[1] = zero16();
  float m = -INFINITY, l = 0.f;
  const unsigned* mrow = MW + (size_t)(b * 4096 + q0 + r) * 128 + h;
  const float bfar = tb[hd * 128 + 127];
  auto stage_all = [&](int buf, int j) {
    st.stage(smem, buf, j);
    __builtin_amdgcn_global_load_lds((const void __attribute__((address_space(1)))*)(mrow + 2 * j), (lds_ptr_t)(smem + buf * ABUF + 16384 + wid * 256 + lane * 4), 4, 0, 0);
  };
  __syncthreads();
#pragma unroll 1
  for (int j = 0; j < RING - 1 && j < ntile; ++j) stage_all(j, j);
  ring_wait_barrier<3>((ntile - 1 < RING - 2 ? ntile - 1 : RING - 2));
#pragma unroll 1
  for (int j = 0; j < ntile; ++j) {
    if (j + RING - 1 < ntile) stage_all((j + RING - 1) & (RING - 1), j + RING - 1);
    const char* B = smem + (j & (RING - 1)) * ABUF;
#pragma unroll
    for (int u = 0; u < 2; ++u) {
      const unsigned word = *(const unsigned*)(B + 16384 + wid * 256 + (u * 32 + r) * 4);
      if (__ballot(word != 0u) != 0ULL) {
        const int key0 = 64 * j + 32 * u;
        const unsigned wh = word >> (4 * h);
        f32x16 s = qk_lds(B, u, r, h, qf);
        if (q0 - key0 - 31 >= 113) {
#pragma unroll
          for (int i = 0; i < 16; ++i) s[i] += bfar;
        } else {
#pragma unroll
          for (int i = 0; i < 16; ++i) { int dist = q0 + r - key0 - CROW(i, h); dist = dist < 0 ? 0 : (dist > 127 ? 127 : dist); s[i] += tb[hd * 128 + dist]; }
        }
#pragma unroll
        for (int i = 0; i < 16; ++i) { const int bit = (i & 3) + 8 * (i >> 2); if (!((wh >> bit) & 1u)) s[i] = -INFINITY; }
        online_softmax(s, m, l, o);
        pv_lds(o, B + 8192, u, r, h, s);
      }
    }
    if (j + 1 < ntile) ring_wait_barrier<3>((ntile - 1 < j + RING - 1 ? ntile - 1 : j + RING - 1) - (j + 1));
  }
  l += __shfl_xor(l, 32);
  store_ot(O + (size_t)(b * 4096 + q0 + r) * 1024 + 768 + hd * 64, o, 1.f / l, h);
}

constexpr int IBUF = 32768;
DI void idx_block(const Params& p, int b, int qb, char* smem) {
  char* wsq = opqp(p.ws);
  const bf16_t* P = (const bf16_t*)(wsq + OFF_P); const float* IW = (const float*)(wsq + OFF_IW); float* SC = (float*)(wsq + OFF_R);
  const int tid = tidx(), lane = tid & 63, wid = __builtin_amdgcn_readfirstlane(tid >> 6), r = lane & 31, h = lane >> 5;
  const int kp = wid >> 1, q0 = qb * 64 + 32 * (wid & 1), tok = b * 4096 + q0 + r, nround = (qb >> 2) + 1;
  const int srow = tid >> 3, sch = tid & 7, fs = (srow >> 1) & 7;
  const bf16_t* kg = P + (size_t)(b * 4096 + srow) * PW + U_IK * 64 + ((sch ^ fs) << 3);
  auto stage = [&](int buf, int R) {
    char* B = smem + buf * IBUF;
#pragma unroll
    for (int i = 0; i < 4; ++i) glds16(kg + (size_t)(256 * R + 64 * i) * PW, B + i * 8192 + tid * 16);
  };
  bf16x8 qf[4][4];
#pragma unroll
  for (int hh = 0; hh < 4; ++hh) load_qf(qf[hh], P + (size_t)tok * PW + (U_IQ + hh) * 64 + 8 * h);
  const f32x4 w = *(const f32x4*)(IW + (size_t)tok * 4);
  float* row = SC + sc_row_off(b, q0 + r) + 4 * h;
  stage(0, 0);
  asm volatile("s_waitcnt vmcnt(0)" ::: "memory");
  __syncthreads();
  f32x16 pend[2]; int pkey[2] = {-1, -1};
  auto flush = [&]() {
#pragma unroll
    for (int u = 0; u < 2; ++u) if (pkey[u] >= 0) {
#pragma unroll
      for (int g = 0; g < 4; ++g) { f32x4 v = {pend[u][4 * g], pend[u][4 * g + 1], pend[u][4 * g + 2], pend[u][4 * g + 3]}; *(f32x4*)(row + pkey[u] + 8 * g) = v; }
    }
  };
#pragma unroll 1
  for (int R = 0; R < nround; ++R) {
    if (R + 1 < nround) stage((R + 1) & 1, R + 1);
    flush();
    const char* KB = smem + (R & 1) * IBUF + kp * 8192;
#pragma unroll
    for (int u = 0; u < 2; ++u) {
      const int key0 = 256 * R + 64 * kp + 32 * u;
      pkey[u] = -1;
      if (key0 <= q0) {
        bf16x8 kf[4];
#pragma unroll
        for (int ks = 0; ks < 4; ++ks) kf[ks] = lds_frag(KB, 32 * u + r, 2 * ks + h);
        f32x16 sc = zero16();
#pragma unroll
        for (int hh = 0; hh < 4; ++hh) {
          f32x16 acc = zero16();
#pragma unroll
          for (int ks = 0; ks < 4; ++ks) acc = MFMA32(kf[ks], qf[hh][ks], acc);
#pragma unroll
          for (int i = 0; i < 16; ++i) sc[i] += w[hh] * fmaxf(acc[i], 0.f);
          __builtin_amdgcn_sched_barrier(0);
        }
#pragma unroll
        for (int i = 0; i < 16; ++i) sc[i] += 0.f;
        if (key0 == q0) {
#pragma unroll
          for (int i = 0; i < 16; ++i) if (CROW(i, h) > r) sc[i] = -INFINITY;
        }
        pend[u] = sc; pkey[u] = key0;
      }
    }
    asm volatile("s_waitcnt vmcnt(0)" ::: "memory");
    __syncthreads();
  }
  flush();
}

DI void build_bias_table(const Params& p, float* tb, int hoff) {
  for (int i = tidx(); i < 512; i += NTHR) { const int hd = i >> 7, dist = i & 127; tb[i] = p.t5[T5B[dist] * 8 + hoff + hd] * LOG2E; }
  __syncthreads();
}

DI int wave_sum_i(int v) {
  int tot = 0;
#pragma unroll
  for (int b = 0; b < 7; ++b) tot += __builtin_popcountll(__ballot((v >> b) & 1)) << b;
  return tot;
}
DI float wave_min(float v) { for (int o = 32; o > 0; o >>= 1) v = fminf(v, __shfl_xor(v, o)); return v; }
DI unsigned f2key(float f) { unsigned b = __float_as_uint(f); return (b & 0x80000000u) ? ~b : (b | 0x80000000u); }
DI float key2f(unsigned k) { return __uint_as_float((k & 0x80000000u) ? (k & 0x7fffffffu) : ~k); }
DI void dsa_select2(const Params& p, int item, int lane) {
  char* wsq = opqp(p.ws);
  const float* SC = (const float*)(wsq + OFF_R); u64* MASK = (u64*)(wsq + OFF_MASK);
  const int t = item & 4095, b = item >> 12, tok = b * 4096 + t;
  const float* row = SC + sc_row_off(b, t);
  u64 myword = 0;
  if (t < 256) {
#pragma unroll
    for (int r = 0; r < 4; ++r) { u64 w = __ballot((r * 64 + lane) <= t); if (lane == r) myword = w; }
  } else {
    const int nch = (t >> 10) + 1;
    f32x2 xp[32];
#define XS(r) xp[(r) >> 1][(r) & 1]
#pragma unroll
    for (int c = 0; c < 4; ++c) {
      if (c < nch) {
#pragma unroll
        for (int rr = 0; rr < 16; ++rr) { const int r = c * 16 + rr, s = r * 64 + lane; XS(r) = (s <= t) ? row[s] : -INFINITY; }
      } else {
#pragma unroll
        for (int rr = 0; rr < 16; ++rr) XS(c * 16 + rr) = -INFINITY;
      }
    }
    auto count_ge = [&](float v) -> int {
      const f32x2 vv = {v, v};
      int lt = 0;
#pragma unroll
      for (int c = 0; c < 4; ++c) if (c < nch) {
#pragma unroll
        for (int q = 0; q < 8; ++q) {
          f32x2 d;
          asm("v_pk_add_f32 %0, %1, %2 neg_lo:[0,1] neg_hi:[0,1]" : "=v"(d) : "v"(xp[c * 8 + q]), "v"(vv));
          lt += (int)(__float_as_uint(d[0]) >> 31) + (int)(__float_as_uint(d[1]) >> 31);
        }
      }
      return nch * 1024 - (wave_sum_i(lt & 127) + ((__builtin_popcountll(__ballot(lt >> 7))) << 7));
    };
    float mx = -INFINITY, mn = INFINITY;
#pragma unroll
    for (int c = 0; c < 4; ++c) if (c < nch) {
#pragma unroll
      for (int rr = 0; rr < 16; ++rr) { const float v = XS(c * 16 + rr); mx = fmaxf(mx, v); mn = fminf(mn, v == -INFINITY ? INFINITY : v); }
    }
    mx = wave_max(mx); mn = wave_min(mn);
    float T = mx; bool exact = false;
    int chi = count_ge(mx);
    if (chi < 256) {
      float lo = mn, hi = mx; int clo = t + 1;
      if (lo < 0.f && hi > 0.f) { const int c0 = count_ge(0.f); if (c0 >= 256) { lo = 0.f; clo = c0; } else { hi = 0.f; chi = c0; } }
      float glo = __builtin_amdgcn_logf((float)clo + 0.5f) - 8.0028150f, ghi = __builtin_amdgcn_logf((float)chi + 0.5f) - 8.0028150f;
      int side = 0; bool conv = false;
      for (int it = 0; it < 40; ++it) {
        if (clo == 256) { T = lo; exact = true; break; }
        const float frac = fminf(fmaxf(glo / (glo - ghi), 0.01f), 0.99f);
        float mid = lo + (hi - lo) * frac;
        if (!(mid > lo && mid < hi)) { mid = lo + (hi - lo) * 0.5f; if (!(mid > lo && mid < hi)) { conv = true; break; } }
        const int c = count_ge(mid);
        if (c == 256) { T = mid; exact = true; break; }
        const float gm = __builtin_amdgcn_logf((float)c + 0.5f) - 8.0028150f;
        if (c > 256) { lo = mid; clo = c; glo = gm; if (side == 1) ghi *= 0.5f; side = 1; }
        else { hi = mid; chi = c; ghi = gm; if (side == -1) glo *= 0.5f; side = -1; }
      }
      if (!exact) {
        if (!conv) {
          unsigned klo = f2key(lo), khi = f2key(hi);
          while (khi - klo > 1u) {
            const unsigned km = klo + ((khi - klo) >> 1);
            const int c = count_ge(key2f(km));
            if (c == 256) { klo = km; exact = true; break; }
            if (c > 256) klo = km; else khi = km;
          }
          lo = key2f(klo);
        }
        T = lo;
      }
    }
    int need = 4096;
    if (!exact) {
      int cgt = 0;
#pragma unroll
      for (int c = 0; c < 4; ++c) if (c < nch) {
#pragma unroll
        for (int rr = 0; rr < 16; ++rr) cgt += (XS(c * 16 + rr) > T) ? 1 : 0;
      }
      need = 256 - wave_sum_i(cgt);
    }
    if (exact) {
#pragma unroll
      for (int c = 0; c < 4; ++c) if (c < nch) {
#pragma unroll
        for (int rr = 0; rr < 16; ++rr) { const int r = c * 16 + rr; const u64 w = __ballot(XS(r) >= T); if (lane == r) myword = w; }
      }
    } else
#pragma unroll
    for (int c = 0; c < 4; ++c) if (c < nch) {
#pragma unroll
      for (int rr = 0; rr < 16; ++rr) {
        const int r = c * 16 + rr;
        const u64 gt = __ballot(exact ? (XS(r) >= T) : (XS(r) > T));
        u64 eq = __ballot(!exact && XS(r) == T);
        if (eq) {
          int ne = __builtin_popcountll(eq);
          if (ne > need) { int drop = ne - need; while (drop-- > 0) eq &= ~(1ULL << (63 - __builtin_clzll(eq))); ne = need; }
          need -= ne;
        }
        const u64 w = gt | eq;
        if (lane == r) myword = w;
      }
    }
  }
  MASK[(size_t)tok * 64 + lane] = myword;
}

DI void phase_attn1(const Params& p, int layer, int bid, int nblk, char* smem) {
  const int lane = tidx() & 63, wid = __builtin_amdgcn_readfirstlane(tidx() >> 6);
  phase_cumsum(p, bid, nblk);
  for (int pr = bid; pr < 256; pr += nblk) { const int bh = pr & 31, i = pr >> 5;
#pragma unroll 1
    for (int k = 0; k < 2; ++k) sb_block(p, bh >> 2, bh & 3, k ? i : 15 - i, smem); }
  for (int pr = bid; pr < 256; pr += nblk) { const int b = pr & 7, i = pr >> 3;
#pragma unroll 1
    for (int k = 0; k < 2; ++k) {
      const int qb = k ? i : 63 - i;
      idx_block(p, b, qb, smem);
      __syncthreads();
#pragma unroll 1
      for (int j = 0; j < 8; ++j) dsa_select2(p, b * 4096 + qb * 64 + wid * 8 + j, lane);
    } }
  { float* tb = (float*)(smem + RING * ABUF + 64); __syncthreads(); build_bias_table(p, tb, 0);
    for (int it = bid; it < 256; it += nblk) swa_block(p, layer, it & 7, (it >> 3) & 1, it >> 4, smem, tb);
    __syncthreads(); }
}
DI void phase_attn2(const Params& p, int layer, int bid, int nblk, char* smem) {
  for (int pr = bid; pr < 256; pr += nblk) { const int bh = pr & 31, i = pr >> 5;
#pragma unroll 1
    for (int k = 0; k < 2; ++k) fox_block(p, bh >> 2, bh & 3, k ? i : 15 - i, smem); }
  __syncthreads();
  float* tb = (float*)(smem + RING * ABUF); build_bias_table(p, tb, 4);
  for (int pr = bid; pr < 256; pr += nblk) { const int b = pr & 7, i = pr >> 3;
#pragma unroll 1
    for (int k = 0; k < 2; ++k) dsa_block(p, b, k ? i : 63 - i, smem, tb); }
  __syncthreads();
}

DI void phase_gates(const Params& p, int layer, int bid, int nblk, char* smem) {
  char* wsq = opqp(p.ws);
  const bf16_t* hb = (const bf16_t*)(wsq + OFF_HB);
  const bf16_t* wt = (const bf16_t*)(wsq + OFF_WIN) + ((size_t)layer * 6912 + PW) * 1024;
  TILE_LOOP(128, 16, mt, nt) {
    f32x4 acc[8][4]; zero_acc(acc);
#if K8_GATES
    gemm_kloop8(acc, RowsDense{hb + (size_t)mt * 256 * DM, DM}, wt + (size_t)nt * 256 * DM, DM, DM, smem);
#else
    gemm_kloop<8>(acc, RowsDense{hb + (size_t)mt * 256 * DM, DM}, wt + (size_t)nt * 256 * DM, DM, DM, smem);
#endif
#pragma unroll
    for (int m = 0; m < 8; ++m)
#pragma unroll
      for (int n = 0; n < 4; ++n)
#pragma unroll
        for (int j = 0; j < 4; ++j) acc[m][n][j] = sigmoid_fast(acc[m][n][j]);
    const int t2 = tidx(), ln = t2 & 63, wid2 = t2 >> 6;
    unsigned char* G = (unsigned char*)(opqp(wsq) + OFF_R);
    unsigned char* gb = G + (size_t)(mt * 256 + (wid2 >> 2) * 128) * 4096 + nt * 256 + (wid2 & 3) * 64;
    store_tile_u8<8>(acc, smem, wid2, ln, [&](int row) { return gb + (size_t)row * 4096; });
#if K8_GATES
    k8_tile_end();
#endif
  }
}

DI void phase_merge(const Params& p, int layer, int bid, int nblk, char* smem) {
  char* wsq = opqp(p.ws);
  const bf16_t* O = (const bf16_t*)(wsq + OFF_O); const unsigned char* G = (const unsigned char*)(wsq + OFF_R);
  const bf16_t* wt = (const bf16_t*)(wsq + OFF_WBR) + (size_t)layer * 1024 * 1024;
  bf16_t* MG = (bf16_t*)(wsq + OFF_MG);
  constexpr int MST = 24576, MRING = 4;
  TILE_LOOP(256, 4, mt, nt) {
    const int tid = tidx(), wid = tid >> 6, lane = tid & 63, wr = wid >> 2, wc = wid & 3, fr = lane & 15, fq = lane >> 4;
    const int srow = tid >> 2, sg = ((srow >> 3) & 1) * 3, sch = (tid & 3) ^ sg;
    const bf16_t* asrc = O + (size_t)(mt * 128 + srow) * 1024 + sch * 8;
    const bf16_t* bsrc0 = wt + (size_t)(nt * 256 + srow) * 1024 + sch * 8;
    const bf16_t* bsrc1 = bsrc0 + (size_t)128 * 1024;
    auto stage = [&](int buf, int ks) {
      char* B = smem + buf * MST;
      glds16(asrc + ks * 32, B + tid * 16);
      glds16(bsrc0 + ks * 32, B + 8192 + tid * 16);
      glds16(bsrc1 + ks * 32, B + 16384 + tid * 16);
    };
    const int grow = tid >> 4;
    const unsigned char* gsrc = G + (size_t)(mt * 128 + grow) * 4096 + nt * 256 + (((tid & 15) ^ (grow & 15)) << 4);
    auto stage_g = [&](int b) {
#pragma unroll
      for (int q = 0; q < 4; ++q) glds16(gsrc + b * 1024 + (size_t)q * 32 * 4096, smem + MRING * MST + (tid + 512 * q) * 16);
    };
    int aoff[4], boff[4];
#pragma unroll
    for (int m = 0; m < 4; ++m) { const int r = wr * 64 + m * 16 + fr; aoff[m] = r * 64 + ((fq ^ (((r >> 3) & 1) * 3)) << 4); }
#pragma unroll
    for (int n = 0; n < 4; ++n) { const int r = wc * 64 + n * 16 + fr; boff[n] = 8192 + r * 64 + ((fq ^ (((r >> 3) & 1) * 3)) << 4); }
    f32x4 macc[4][4]; zero_acc(macc);
    f32x4 acc[4][4]; zero_acc(acc);
    __syncthreads();
    stage(0, 0); stage(1, 1); stage(2, 2); stage_g(0);
    asm volatile("s_waitcnt vmcnt(10)" ::: "memory"); __builtin_amdgcn_s_barrier(); asm volatile("" ::: "memory");
#pragma unroll 1
    for (int ks = 0; ks < 32; ++ks) {
      if (ks + 3 < 32) stage((ks + 3) & (MRING - 1), ks + 3);
      if (ks && (ks & 7) == 0) stage_g(ks >> 3);
      const char* B = smem + (ks & (MRING - 1)) * MST;
      bf16x8 af[4], bfr[4];
#pragma unroll
      for (int n = 0; n < 4; ++n) bfr[n] = *(const bf16x8*)(B + boff[n]);
#pragma unroll
      for (int m = 0; m < 4; ++m) af[m] = *(const bf16x8*)(B + aoff[m]);
#pragma unroll
      for (int m = 0; m < 4; ++m)
#pragma unroll
        for (int n = 0; n < 4; ++n) acc[m][n] = __builtin_amdgcn_mfma_f32_16x16x32_bf16(bfr[n], af[m], acc[m][n], 0, 0, 0);
      if ((ks & 7) == 7) {
        const char* gp = smem + MRING * MST + (wr * 64 + fr) * 256 + fq * 4;
        unsigned gv[4][4];
#pragma unroll
        for (int m = 0; m < 4; ++m)
#pragma unroll
          for (int n = 0; n < 4; ++n) gv[m][n] = *(const unsigned*)(gp + m * 16 * 256 + (((wc * 4 + n) ^ fr) << 4));
        __builtin_amdgcn_sched_barrier(0);
#pragma unroll
        for (int m = 0; m < 4; ++m)
#pragma unroll
          for (int n = 0; n < 4; ++n) {
            const unsigned g = gv[m][n];
            macc[m][n][0] += ((float)(g & 255u) * (1.f / 255.f)) * acc[m][n][0];
            macc[m][n][1] += ((float)((g >> 8) & 255u) * (1.f / 255.f)) * acc[m][n][1];
            macc[m][n][2] += ((float)((g >> 16) & 255u) * (1.f / 255.f)) * acc[m][n][2];
            macc[m][n][3] += ((float)(g >> 24) * (1.f / 255.f)) * acc[m][n][3];
            acc[m][n] = (f32x4){0.f, 0.f, 0.f, 0.f};
          }
      }
      if (ks + 1 < 32) {
        if ((ks & 7) <= 2) { asm volatile("s_waitcnt vmcnt(10)" ::: "memory"); asm volatile("s_waitcnt lgkmcnt(0)" ::: "memory"); __builtin_amdgcn_s_barrier(); asm volatile("" ::: "memory"); }
        else ring_wait_barrier<3>((31 < ks + 3 ? 31 : ks + 3) - (ks + 1));
      }
    }
    __syncthreads();
    {
      bf16_t* mb = MG + (size_t)(mt * 128 + wr * 64) * 1024 + nt * 256 + wc * 64;
      store_tile_bf16<4>(macc, smem, wid, lane, [&](int row) { return mb + (size_t)row * 1024; });
    }
  }
}

DI void phase_outproj(const Params& p, int layer, int bid, int nblk, char* smem) {
  char* wsq = opqp(p.ws);
  const bf16_t* MG = (const bf16_t*)(wsq + OFF_MG);
  const bf16_t* wt = (const bf16_t*)(wsq + OFF_WOUT) + (size_t)layer * 1024 * 1024;
  TILE_LOOP(128, 4, mt, nt) {
    f32x4 acc[8][4]; zero_acc(acc);
    gemm_kloop8(acc, RowsDense{MG + (size_t)mt * 256 * 1024, 1024}, wt + (size_t)nt * 256 * 1024, 1024, 1024, smem);
    const int t2 = tidx(), lane2 = t2 & 63, wid2 = t2 >> 6, wr = wid2 >> 2, wc = wid2 & 3, fr = lane2 & 15, fq = lane2 >> 4;
    float* out2 = opqp(p.out); const float* xin2 = layer == 0 ? opqp(p.x) : out2;
#pragma unroll
    for (int m = 0; m < 8; ++m) {
      const int tok = mt * 256 + wr * 128 + m * 16 + fr;
#pragma unroll
      for (int n = 0; n < 4; ++n) {
        const int col = nt * 256 + wc * 64 + n * 16 + fq * 4;
        f32x4 xv = *(const f32x4*)(xin2 + (size_t)tok * 1024 + col);
        *(f32x4*)(out2 + (size_t)tok * 1024 + col) = xv + acc[m][n];
      }
      __builtin_amdgcn_sched_barrier(0);
    }
    k8_tile_end();
  }
}

DI void phase_router2(const Params& p, int layer, int bid, int nblk, char* smem) {
  char* wsq = opqp(p.ws);
  const int lane = tidx() & 63, wid = __builtin_amdgcn_readfirstlane(tidx() >> 6), grp64 = wid >> 2, kw = wid & 3;
  phase_norm(p.out, p.norm_ffn_g + (size_t)layer * DM, (bf16_t*)(wsq + OFF_HB), bid, nblk);
  float* part = (float*)smem + grp64 * (4 * 37 * 64);
  int* TOKE = (int*)(wsq + OFF_TOKE); float* TOKG = (float*)(wsq + OFF_TOKG); int* TCNT = (int*)(wsq + OFF_TCNT);
  int* lcnt = (int*)(smem + 2 * 4 * 37 * 64 * 4);
  typedef const __attribute__((address_space(4))) float cfloat;
  cfloat* g = (cfloat*)(p.norm_ffn_g + (size_t)layer * DM + kw * 256);
  const float* wrg = p.w_rg + (size_t)layer * DM * 4; const float* wre = p.w_re + (size_t)layer * DM * 32;
  const int tid_ = tidx();
  for (int tile = bid; tile < NT / 128; tile += nblk) {
    const int tok = tile * 128 + grp64 * 64 + lane;
    const float* xr = p.out + (size_t)tok * DM + kw * 256;
    float acc[36]; float ss = 0.f;
#pragma unroll
    for (int e = 0; e < 36; ++e) acc[e] = 0.f;
#pragma unroll 1
    for (int hf = 0; hf < 2; ++hf) {
      __syncthreads();
#pragma unroll
      for (int i = 0; i < 9; ++i) {
        const int c = tid_ + 512 * i, kq = c / 1152, rem = c % 1152, k = rem / 9, j = rem % 9;
        const int kk = kq * 256 + hf * 128 + k;
        const float* src = (j < 8) ? (wre + (size_t)kk * 32 + 4 * j) : (wrg + (size_t)kk * 4);
        glds16(src, smem + c * 16);
      }
      asm volatile("s_waitcnt vmcnt(0)" ::: "memory");
      __syncthreads();
      const float* wimg = (const float*)smem + kw * 128 * 36;
#pragma unroll 1
      for (int k4 = 0; k4 < 128; k4 += 4) {
        const f32x4 xv = *(const f32x4*)(xr + hf * 128 + k4);
#pragma unroll
        for (int j = 0; j < 4; ++j) {
          const int k = k4 + j; const float x = xv[j]; ss += x * x; const float xg = x * g[hf * 128 + k];
          const float* wk = wimg + k * 36;
#pragma unroll
          for (int e4 = 0; e4 < 9; ++e4) {
            const f32x4 w = *(const f32x4*)(wk + 4 * e4);
#pragma unroll
            for (int e = 0; e < 4; ++e) acc[4 * e4 + e] += xg * w[e];
          }
        }
      }
    }
    __syncthreads();
    if (tidx() < 32) lcnt[tidx()] = 0;
#pragma unroll
    for (int e = 0; e < 36; ++e) part[(kw * 37 + e) * 64 + lane] = acc[e];
    part[(kw * 37 + 36) * 64 + lane] = ss;
    __syncthreads();
    if (kw == 0) {
      float lg[36];
#pragma unroll
      for (int e = 0; e < 36; ++e) lg[e] = (part[e * 64 + lane] + part[(37 + e) * 64 + lane]) + (part[(74 + e) * 64 + lane] + part[(111 + e) * 64 + lane]);
      const float sst = (part[36 * 64 + lane] + part[(37 + 36) * 64 + lane]) + (part[(74 + 36) * 64 + lane] + part[(111 + 36) * 64 + lane]);
      const float r = rsqrtf(sst * (1.f / DM) + 1e-6f);
#pragma unroll
      for (int e = 0; e < 32; ++e) lg[e] = lg[e] * r + p.b_re[layer * 32 + e];
#pragma unroll
      for (int e = 0; e < 4; ++e) lg[32 + e] = lg[32 + e] * r + p.b_rg[layer * 4 + e];
      int grp = 0; float gm = lg[32];
#pragma unroll
      for (int e = 1; e < 4; ++e) if (lg[32 + e] > gm) { gm = lg[32 + e]; grp = e; }
      float gs = 0.f;
#pragma unroll
      for (int e = 0; e < 4; ++e) gs += expf(lg[32 + e] - gm);
      const float p_grp = 1.f / gs;
      float ei[8];
#pragma unroll
      for (int j = 0; j < 8; ++j) ei[j] = grp == 0 ? lg[j] : (grp == 1 ? lg[8 + j] : (grp == 2 ? lg[16 + j] : lg[24 + j]));
      float em = ei[0];
#pragma unroll
      for (int j = 1; j < 8; ++j) em = fmaxf(em, ei[j]);
      float pe[8]; float es = 0.f;
#pragma unroll
      for (int j = 0; j < 8; ++j) { pe[j] = expf(ei[j] - em); es += pe[j]; }
#pragma unroll
      for (int j = 0; j < 8; ++j) pe[j] = pe[j] / es;
      int i0 = 0; float p0 = pe[0];
#pragma unroll
      for (int j = 1; j < 8; ++j) if (pe[j] > p0) { p0 = pe[j]; i0 = j; }
      int i1 = -1; float p1 = -1.f;
#pragma unroll
      for (int j = 0; j < 8; ++j) if (j != i0 && pe[j] > p1) { p1 = pe[j]; i1 = j; }
      const float den = p0 + p1;
      const int e0 = grp * 8 + i0, e1 = grp * 8 + i1;
      const int r0 = atomicAdd(&lcnt[e0], 1), r1 = atomicAdd(&lcnt[e1], 1);
      TOKE[tok * 2] = e0 | (r0 << 8); TOKE[tok * 2 + 1] = e1 | (r1 << 8);
      TOKG[tok * 2] = p_grp * p0 / den; TOKG[tok * 2 + 1] = p_grp * p1 / den;
    }
    __syncthreads();
    if (tidx() < 32) TCNT[tile * 32 + tidx()] = lcnt[tidx()];
  }
}

DI void load_expert_table(const Params& p, int layer, int* tab) {
  char* wsq = opqp(p.ws);
  const int* CNT = (const int*)(wsq + OFF_CNT) + layer * 64;
  if (tidx() == 0) {
    int acc = 0;
    for (int e = 0; e < 32; ++e) { int c = CNT[e]; int pad = (c + 255) / 256 * 256; tab[e] = acc; acc += pad; tab[32 + e] = acc; tab[64 + e] = c; }
  }
  __syncthreads();
}
DI void phase_slots(const Params& p, int layer, int bid, int nblk, char* smem) {
  char* wsq = opqp(p.ws);
  const int* TOKE = (const int*)(wsq + OFF_TOKE); const float* TOKG = (const float*)(wsq + OFF_TOKG); const int* TCNT = (const int*)(wsq + OFF_TCNT);
  int* CNT = (int*)(wsq + OFF_CNT) + layer * 64; int* SLT = (int*)(wsq + OFF_SLT); float* SLG = (float*)(wsq + OFF_SLG); int* TPOS = (int*)(wsq + OFF_TPOS);
  int* pre = (int*)smem;
  int* pst = pre + 256 * 32;
  const int t = tidx();
  for (int i = t; i < 256 * 32; i += NTHR) pre[i] = TCNT[i];
  __syncthreads();
  if (t < 32) { int run = 0; for (int tl = 0; tl < 256; ++tl) { const int c = pre[tl * 32 + t]; pre[tl * 32 + t] = run; run += c; } pst[32 + t] = run; }
  __syncthreads();
  if (t == 0) { int acc = 0; for (int e = 0; e < 32; ++e) { const int c = pst[32 + e]; pst[e] = acc; acc += (c + 255) / 256 * 256; } }
  __syncthreads();
  if (bid == 0 && t < 32) CNT[t] = pst[32 + t];
  for (int a = bid * NTHR + t; a < 2 * NT; a += nblk * NTHR) {
    const int v = TOKE[a], e = v & 255, rk = v >> 8, tile = a >> 8;
    const int pos = pst[e] + pre[tile * 32 + e] + rk;
    SLT[pos] = a >> 1; SLG[pos] = TOKG[a]; TPOS[a] = pos;
  }
  __syncthreads();
}

struct RowsGather { const bf16_t* base; const int* slt; int slot0; int nvalid; DI const bf16_t* operator()(int r) const { int tok = (r < nvalid) ? slt[slot0 + r] : 0; return base + (size_t)tok * DM; } DI unsigned off(int r) const { int tok = (r < nvalid) ? slt[slot0 + r] : 0; return (unsigned)tok * (unsigned)DM; } static constexpr bool kDense = false; };
DI void phase_up(const Params& p, int layer, int bid, int nblk, char* smem) {
  char* wsq = opqp(p.ws);
  int* tab = (int*)(smem + 2 * GSTAGE); load_expert_table(p, layer, tab);
  const bf16_t* hb = (const bf16_t*)(wsq + OFF_HB); const int* SLT = (const int*)(wsq + OFF_SLT);
  const bf16_t* wt = (const bf16_t*)(wsq + OFF_UP) + (size_t)layer * 32 * 1024 * 1024;
  const int ntiles_m = tab[63] / 256;
  TILE_LOOP(ntiles_m, 4, mt, nt) {
    const int slot0 = mt * 256;
    int e = 0;
    for (int k = 0; k < 32; ++k) if (slot0 >= tab[32 + k]) e = k + 1;
    const int nvalid = tab[e] + tab[64 + e] - slot0;
    f32x4 acc[8][4]; zero_acc(acc);
#if K8_UP
    gemm_kloop8(acc, RowsGather{hb, SLT, slot0, nvalid}, wt + ((size_t)e * 1024 + nt * 256) * 1024, 1024, 1024, smem);
#else
    gemm_kloop<8>(acc, RowsGather{hb, SLT, slot0, nvalid}, wt + ((size_t)e * 1024 + nt * 256) * 1024, 1024, 1024, smem);
#endif
    const int t2 = tidx(), lane = t2 & 63, wid = t2 >> 6, wr = wid >> 2, wc = wid & 3;
    bf16_t* ACT = (bf16_t*)(opqp(wsq) + OFF_ACT);
    f32x4 av[8][2];
#pragma unroll
    for (int m = 0; m < 8; ++m)
#pragma unroll
      for (int n2 = 0; n2 < 2; ++n2) {
        const f32x4 gv = acc[m][2 * n2], uv = acc[m][2 * n2 + 1];
#pragma unroll
        for (int j = 0; j < 4; ++j) av[m][n2][j] = gv[j] * sigmoid_fast(gv[j]) * uv[j];
      }
    {
      const int ln = opq(lane);
      bf16_t* ab = ACT + (size_t)(slot0 + wr * 128) * EFF + nt * 128 + wc * 32;
      store_tile_bf16_32<8>(av, smem, wid, ln, [&](int row) { return ab + (size_t)row * EFF; });
    }
    k8_tile_end();
  }
  __syncthreads();
}
DI void phase_down(const Params& p, int layer, int bid, int nblk, char* smem) {
  char* wsq = opqp(p.ws);
  int* tab = (int*)(smem + 2 * GSTAGE); load_expert_table(p, layer, tab);
  const bf16_t* ACT = (const bf16_t*)(wsq + OFF_ACT);
  const bf16_t* wt = (const bf16_t*)(wsq + OFF_DOWN) + (size_t)layer * 32 * 1024 * 512;
  const int ntiles_m = tab[63] / 256;
  TILE_LOOP(ntiles_m, 4, mt, nt) {
    const int slot0 = mt * 256;
    int e = 0;
    for (int k = 0; k < 32; ++k) if (slot0 >= tab[32 + k]) e = k + 1;
    f32x4 acc[8][4]; zero_acc(acc);
    gemm_kloop8(acc, RowsDense{ACT + (size_t)slot0 * EFF, EFF}, wt + ((size_t)e * 1024 + nt * 256) * 512, 512, 512, smem);
    const int t2 = tidx(), lane = t2 & 63, wid = t2 >> 6, wr = wid >> 2, wc = wid & 3;
    bf16_t* Y = (bf16_t*)(opqp(wsq) + OFF_Y);
    {
      const int ln = opq(lane);
      bf16_t* yb = Y + (size_t)(slot0 + wr * 128) * 1024 + nt * 256 + wc * 64;
      store_tile_bf16<8>(acc, smem, wid, ln, [&](int row) { return yb + (size_t)row * 1024; });
    }
    k8_tile_end();
  }
  __syncthreads();
}
DI void phase_combine(const Params& p, int layer, int bid, int nblk) {
  char* wsq = opqp(p.ws);
  const bf16_t* Y = (const bf16_t*)(wsq + OFF_Y); const int* TPOS = (const int*)(wsq + OFF_TPOS); const float* TOKG = (const float*)(wsq + OFF_TOKG);
  bf16_t* hb = (bf16_t*)(wsq + OFF_HB); const float* gn = p.norm_mix_g + DM;
  const int lane = tidx() & 63, wid = tidx() >> 6;
  for (int tok = bid * NWV + wid; tok < NT; tok += nblk * NWV) {
    const int p0 = TPOS[tok * 2], p1 = TPOS[tok * 2 + 1]; const float g0 = TOKG[tok * 2], g1 = TOKG[tok * 2 + 1];
    f32x4 xo[4]; float ss = 0.f;
#pragma unroll
    for (int i = 0; i < 4; ++i) {
      const int c = lane * 4 + 256 * i;
      f32x4 xv = *(const f32x4*)(p.out + (size_t)tok * DM + c);
      const u32x2 a = *(const u32x2*)(Y + (size_t)p0 * DM + c), bq = *(const u32x2*)(Y + (size_t)p1 * DM + c);
      f32x4 y0 = {__uint_as_float(a[0] << 16), __uint_as_float(a[0] & 0xffff0000u), __uint_as_float(a[1] << 16), __uint_as_float(a[1] & 0xffff0000u)};
      f32x4 y1 = {__uint_as_float(bq[0] << 16), __uint_as_float(bq[0] & 0xffff0000u), __uint_as_float(bq[1] << 16), __uint_as_float(bq[1] & 0xffff0000u)};
      xo[i] = xv + (y0 * g0 + y1 * g1);
      *(f32x4*)(p.out + (size_t)tok * DM + c) = xo[i];
      ss += xo[i][0] * xo[i][0] + xo[i][1] * xo[i][1] + xo[i][2] * xo[i][2] + xo[i][3] * xo[i][3];
    }
    if (layer == 0) {
      ss = wave_sum(ss);
      const float r = rsqrtf(ss * (1.f / DM) + 1e-6f);
#pragma unroll
      for (int i = 0; i < 4; ++i) {
        const f32x4 gg = *(const f32x4*)(gn + lane * 4 + 256 * i);
        u32x2 o; o[0] = pack2(xo[i][0] * r * gg[0], xo[i][1] * r * gg[1]); o[1] = pack2(xo[i][2] * r * gg[2], xo[i][3] * r * gg[3]);
        *(u32x2*)(hb + (size_t)tok * DM + lane * 4 + 256 * i) = o;
      }
    }
  }
}

#define XB_TMO      128
#define XB_XCNT(j)  (256  + 64 * (j))
#define XB_XSUB(j)  (1280 + 64 * (j))
#define XB_XGEN(j)  (2304 + 64 * (j))
#define XB_TOP      3328
#define XB_TOPGEN   3392
#define XCD_BAR_WORDS 3456
#define XB_SPIN_CAP (1u << 20)
#define LAS __attribute__((address_space(3)))
DI unsigned xb_ld(unsigned* p)              { return __hip_atomic_load(p, __ATOMIC_RELAXED, __HIP_MEMORY_SCOPE_AGENT); }
DI unsigned xb_add(unsigned* p, unsigned v) { return __hip_atomic_fetch_add(p, v, __ATOMIC_RELAXED, __HIP_MEMORY_SCOPE_AGENT); }
DI unsigned xb_xcc_id() { return (unsigned)__builtin_amdgcn_s_getreg((3 << 11) | 20) & 0xFu; }
#define XB_SPIN(cond, bar) do { unsigned _sp = 0; while (cond) { __builtin_amdgcn_s_sleep(1); \
    if ((++_sp & 255u) == 0u) { if (xb_ld(&(bar)[XB_TMO])) break; if (_sp > XB_SPIN_CAP) { atomicAdd(&(bar)[XB_TMO], 1u); break; } } } } while (0)
struct XcdBarrier { unsigned* bar; unsigned x; volatile LAS unsigned* st; };
DI XcdBarrier xcd_barrier_post(unsigned* bar, volatile LAS unsigned* st) {
  XcdBarrier b; b.bar = bar; b.x = xb_xcc_id(); b.st = st;
  if (threadIdx.x == 0) (void)xb_add(&bar[XB_XCNT(b.x)], 1u);
  return b;
}
DI void xcd_barrier_complete(unsigned* bar, unsigned x, unsigned& nloc, unsigned& nx) {
  const unsigned G = gridDim.x * gridDim.y * gridDim.z;
  unsigned sum, cnt, mine, sp = 0u;
  for (;;) {
    sum = 0u; cnt = 0u; mine = 0u;
#pragma unroll
    for (unsigned j = 0; j < 16; ++j) { const unsigned c = xb_ld(&bar[XB_XCNT(j)]); sum += c; cnt += (c > 0u) ? 1u : 0u; mine = (j == x) ? c : mine; }
    if (sum == G) break;
    __builtin_amdgcn_s_sleep(1);
    if ((++sp & 255u) == 0u) { if (xb_ld(&bar[XB_TMO])) break; if (sp > XB_SPIN_CAP) { atomicAdd(&bar[XB_TMO], 1u); break; } }
  }
  nloc = mine > 0u ? mine : 1u; nx = cnt > 0u ? cnt : 1u;
}
DI void xcd_barrier(const XcdBarrier& b) {
  asm volatile("s_waitcnt vmcnt(0)" ::: "memory");
  __syncthreads();
  if (threadIdx.x == 0) {
    unsigned* bar = opqp(b.bar);
    __builtin_amdgcn_s_waitcnt(0);
    unsigned nloc = b.st[0], nx = b.st[1];
    if (nloc == 0u) { xcd_barrier_complete(bar, b.x, nloc, nx); b.st[0] = nloc; b.st[1] = nx; }
    const unsigned old = xb_add(&bar[XB_XSUB(b.x)], 1u);
    const unsigned gen = old / nloc;
    if (old + 1u == (gen + 1u) * nloc) {
      __builtin_amdgcn_fence(__ATOMIC_RELEASE, "agent");
      asm volatile("s_waitcnt vmcnt(0)" ::: "memory");
      const unsigned og = xb_add(&bar[XB_TOP], 1u);
      const unsigned tg = og / nx;
      if (og + 1u == (tg + 1u) * nx) xb_add(&bar[XB_TOPGEN], 1u);
      else XB_SPIN(xb_ld(&bar[XB_TOPGEN]) == tg, bar);
      __builtin_amdgcn_fence(__ATOMIC_ACQUIRE, "agent");
      xb_add(&bar[XB_XGEN(b.x)], 1u);
      asm volatile("s_waitcnt vmcnt(0)" ::: "memory");
    } else {
      XB_SPIN(xb_ld(&bar[XB_XGEN(b.x)]) == gen, bar);
      __builtin_amdgcn_fence(__ATOMIC_ACQUIRE, "agent");
      asm volatile("s_waitcnt vmcnt(0)" ::: "memory");
    }
  }
  __syncthreads();
}

namespace cg = cooperative_groups;
__global__ void __launch_bounds__(512, 2) mega(Params p) {
  __shared__ __attribute__((aligned(16))) char smem[2 * GSTAGE + 512];
  cg::grid_group grid = cg::this_grid();
  const int bid = blockIdx.x, nblk = gridDim.x;
  unsigned* bar = (unsigned*)(p.ws + OFF_BAR);
  volatile LAS unsigned* xst = (volatile LAS unsigned*)(smem + 2 * GSTAGE + 448);
  if (bid == 0) for (int i = tidx(); i < XCD_BAR_WORDS; i += NTHR) bar[i] = 0u;
  if (tidx() == 0) { xst[0] = 0u; xst[1] = 0u; }
  for (int rep = 0; rep < 1 + PROBE_CV; ++rep) {
  phase_convert(p, bid, nblk, smem);
  phase_norm(p.x, p.norm_mix_g, (bf16_t*)(p.ws + OFF_HB), bid, nblk);
  grid.sync();
  }
  const XcdBarrier xb = xcd_barrier_post(bar, xst);
#define GS() xcd_barrier(xb)
#pragma unroll 1
  for (int layer = 0; layer < 2; ++layer) {
    for (int rep = 0; rep < 1 + PROBE_GEMM; ++rep) { phase_inproj(p, layer, bid, nblk, smem); GS(); }
    for (int rep = 0; rep < 1 + PROBE_A1; ++rep) { phase_attn1(p, layer, bid, nblk, smem); GS(); }
    for (int rep = 0; rep < 1 + PROBE_A2; ++rep) { phase_attn2(p, layer, bid, nblk, smem); GS(); }
    for (int rep = 0; rep < 1 + PROBE_GEMM; ++rep) { phase_gates(p, layer, bid, nblk, smem); GS(); }
    for (int rep = 0; rep < 1 + PROBE_GEMM; ++rep) { phase_merge(p, layer, bid, nblk, smem); GS(); }
    phase_outproj(p, layer, bid, nblk, smem); GS();
    phase_router2(p, layer, bid, nblk, smem); GS();
    phase_slots(p, layer, bid, nblk, smem); GS();
    for (int rep = 0; rep < 1 + PROBE_GEMM; ++rep) { phase_up(p, layer, bid, nblk, smem); GS(); }
    for (int rep = 0; rep < 1 + PROBE_GEMM; ++rep) { phase_down(p, layer, bid, nblk, smem); GS(); }
    phase_combine(p, layer, bid, nblk);
    if (layer == 0) GS();
  }
}

#ifdef PHASE_TEST
template <int PH> __global__ void __launch_bounds__(512, 2) k_phase(Params p, int layer) {
  __shared__ __attribute__((aligned(16))) char smem[2 * GSTAGE + 512];
  const int bid = blockIdx.x, nblk = gridDim.x;
  if (PH == 0) phase_convert(p, bid, nblk, smem);
  if (PH == 1) phase_norm(p.x, p.norm_mix_g, (bf16_t*)(p.ws + OFF_HB), bid, nblk);
  if (PH == 2) phase_inproj(p, layer, bid, nblk, smem);
  if (PH == 3) phase_attn1(p, layer, bid, nblk, smem);
  if (PH == 4) phase_attn2(p, layer, bid, nblk, smem);
  if (PH == 6) phase_gates(p, layer, bid, nblk, smem);
  if (PH == 7) phase_merge(p, layer, bid, nblk, smem);
  if (PH == 8) phase_outproj(p, layer, bid, nblk, smem);
  if (PH == 9) phase_router2(p, layer, bid, nblk, smem);
  if (PH == 10) phase_slots(p, layer, bid, nblk, smem);
  if (PH == 11) phase_up(p, layer, bid, nblk, smem);
  if (PH == 12) phase_down(p, layer, bid, nblk, smem);
  if (PH == 13) phase_combine(p, layer, bid, nblk);
  if (PH == 14) sb_block(p, bid & 7, bid & 3, bid & 15, smem);
  if (PH == 15) idx_block(p, bid & 7, bid & 63, smem);
  if (PH == 16) fast_swa(p, layer, bid & 7, bid & 3, bid & 127, tidx() & 63, (float*)smem);
  if (PH == 17) fox_block(p, bid & 7, bid & 3, bid & 15, smem);
  if (PH == 18) dsa_block(p, bid & 7, bid & 63, smem, (float*)smem + 10000);
  if (PH == 19) dsa_select2(p, bid, tidx() & 63);
}
template __global__ void k_phase<14>(Params, int); template __global__ void k_phase<15>(Params, int); template __global__ void k_phase<16>(Params, int);
template __global__ void k_phase<17>(Params, int); template __global__ void k_phase<18>(Params, int); template __global__ void k_phase<19>(Params, int);
template __global__ void k_phase<0>(Params, int); template __global__ void k_phase<1>(Params, int); template __global__ void k_phase<2>(Params, int);
template __global__ void k_phase<3>(Params, int); template __global__ void k_phase<4>(Params, int); template __global__ void k_phase<5>(Params, int);
template __global__ void k_phase<6>(Params, int); template __global__ void k_phase<7>(Params, int); template __global__ void k_phase<8>(Params, int);
template __global__ void k_phase<9>(Params, int); template __global__ void k_phase<10>(Params, int); template __global__ void k_phase<11>(Params, int);
template __global__ void k_phase<12>(Params, int); template __global__ void k_phase<13>(Params, int);
#endif

extern "C" void kernel_launch(void* const* d_in, const int* in_sizes, int n_in, void* d_out, int out_size, void* d_ws, size_t ws_size,
                              hipStream_t stream) {
  Params p{};
  p.x = (const float*)d_in[0]; p.norm_mix_g = (const float*)d_in[1]; p.w_in = (const float*)d_in[2]; p.forget_bias = (const float*)d_in[3];
  p.attn_sinks = (const float*)d_in[4]; p.qk_gain = (const float*)d_in[5]; p.w_branch = (const float*)d_in[6]; p.w_out = (const float*)d_in[7];
  p.t5 = (const float*)d_in[8]; p.norm_ffn_g = (const float*)d_in[9]; p.w_rg = (const float*)d_in[10]; p.b_rg = (const float*)d_in[11];
  p.w_re = (const float*)d_in[12]; p.b_re = (const float*)d_in[13]; p.w_up = (const float*)d_in[14]; p.w_down = (const float*)d_in[15];
  p.out = (float*)d_out; p.ws = (char*)d_ws;
  if (ws_size < WS_END) { fprintf(stderr, "workspace too small: %zu < %zu\n", ws_size, (size_t)WS_END); return; }
  static int grid_blocks = 0;
  if (!grid_blocks) {
    int dev = 0, cus = 0, per_cu = 0;
    hipGetDevice(&dev);
    hipDeviceGetAttribute(&cus, hipDeviceAttributeMultiprocessorCount, dev);
    hipOccupancyMaxActiveBlocksPerMultiprocessor(&per_cu, mega, NTHR, 0);
    if (per_cu > 1) per_cu = 1;
    if (per_cu < 1) per_cu = 1;
    grid_blocks = cus * per_cu;
  }
  void* args[] = {&p};
  hipError_t e = hipLaunchCooperativeKernel((void*)mega, dim3(grid_blocks), dim3(NTHR), args, 0, stream);
  if (e != hipSuccess) fprintf(stderr, "cooperative launch failed: %s (grid %d)\n", hipGetErrorString(e), grid_blocks);
}
```
